# Optimizing an MI355X kernel written in HIP

```python
import jax, jax.numpy as jnp
from jax import lax
import numpy as np

D_MODEL = 2048
BATCH = 4
SEQ = 8192
DEPTH = 2

GRID_W = 64
HEAD_DIM = 128
D_MIX = D_MODEL
FOURIER_GROUPS = D_MIX // 4 // HEAD_DIM
FOURIER_WIDTH = FOURIER_GROUPS * HEAD_DIM
MEM_HEADS = 4
MEM_WIDTH = MEM_HEADS * HEAD_DIM
NA_WIDTH = D_MIX - FOURIER_WIDTH - MEM_WIDTH
NA_HEADS = NA_WIDTH // HEAD_DIM
NA_KH = 8
NA_KW = 16
N_MEM = 256
D_IN = 3 * NA_WIDTH + FOURIER_WIDTH + MEM_WIDTH
D_FF = ((8 * D_MODEL // 3 + 255) // 256) * 256
EPS = 1e-6

kernel_name = "hybrid_natten_fnet_memory_encoder"


def rms_norm(x, g):
    xf = x.astype(jnp.float32)
    y = xf * lax.rsqrt(jnp.mean(xf * xf, axis=-1, keepdims=True) + EPS)
    return (y * g.astype(jnp.float32)).astype(x.dtype)


def neighbourhood_attention(q, k, v, rpb):
    B, S, H, Dh = q.shape
    rows = S // GRID_W
    kh = min(NA_KH, rows)
    kw = min(NA_KW, GRID_W)
    scale = Dh ** -0.5
    qg = q.reshape(B, rows, GRID_W, H, Dh)
    kg = k.reshape(B, rows, GRID_W, H, Dh)
    vg = v.reshape(B, rows, GRID_W, H, Dh)

    col = jnp.arange(GRID_W)
    col_start = jnp.clip(col - kw // 2, 0, GRID_W - kw)
    col_mask = (col[None, :] >= col_start[:, None]) & (col[None, :] < col_start[:, None] + kw)
    col_idx = jnp.clip(col[None, :] - col[:, None] + NA_KW - 1, 0, 2 * NA_KW - 2)
    bias_col = rpb[:, :, col_idx]

    def one_row(r):
        start = jnp.clip(r - kh // 2, 0, rows - kh)
        q_r = lax.dynamic_index_in_dim(qg, r, axis=1, keepdims=False)
        k_b = lax.dynamic_slice_in_dim(kg, start, kh, axis=1)
        v_b = lax.dynamic_slice_in_dim(vg, start, kh, axis=1)
        s = jnp.einsum('bqhd,bakhd->bhqak', q_r, k_b,
                       preferred_element_type=jnp.float32) * scale
        row_idx = start + jnp.arange(kh) - r + NA_KH - 1
        bias = jnp.take(bias_col, row_idx, axis=1).transpose(0, 2, 1, 3)
        s = s + bias[None].astype(jnp.float32)
        s = jnp.where(col_mask[None, None, :, None, :], s, -jnp.inf)
        p = jax.nn.softmax(s.reshape(B, H, GRID_W, kh * GRID_W), axis=-1)
        p = p.reshape(B, H, GRID_W, kh, GRID_W).astype(v.dtype)
        return jnp.einsum('bhqak,bakhd->bqhd', p, v_b)

    out = lax.map(one_row, jnp.arange(rows))
    return out.transpose(1, 0, 2, 3, 4).reshape(B, S, H * Dh)


def fourier_mix(u, w_f):
    B, S, _ = u.shape
    uf = u.astype(jnp.float32).reshape(B, S, FOURIER_GROUPS, HEAD_DIM)
    y = jnp.fft.fft2(uf, axes=(1, 3), norm="ortho").real
    y = jnp.einsum('bsgc,gce->bsge', y, w_f.astype(jnp.float32))
    return y.reshape(B, S, FOURIER_WIDTH).astype(u.dtype)


def memory_attention(q, mk, mv):
    B, S, H, Dh = q.shape
    s = jnp.einsum('bshd,bmhd->bhsm', q, mk, preferred_element_type=jnp.float32) * (Dh ** -0.5)
    p = jax.nn.softmax(s, axis=-1).astype(mv.dtype)
    return jnp.einsum('bhsm,bmhd->bshd', p, mv).reshape(B, S, H * Dh)


def setup_inputs(seed: int = 0) -> dict:
    key = jax.random.key(seed)
    ks = jax.random.split(key, 20)
    f32 = jnp.float32

    def nrm(k, shape, scale):
        return jax.random.normal(k, shape, f32) * scale

    def gain(k, shape):
        return 1.0 + 0.05 * jax.random.normal(k, shape, f32)

    return {
        "x": jax.random.normal(ks[0], (BATCH, SEQ, D_MODEL), f32),
        "mem": jax.random.normal(ks[1], (BATCH, N_MEM, D_MODEL), f32),
        "attn_norm": gain(ks[2], (DEPTH, D_MODEL)),
        "w_in": nrm(ks[3], (DEPTH, D_MODEL, D_IN), D_MODEL ** -0.5),
        "na_q_norm": gain(ks[4], (DEPTH, HEAD_DIM)),
        "na_k_norm": gain(ks[5], (DEPTH, HEAD_DIM)),
        "na_rpb": nrm(ks[6], (DEPTH, NA_HEADS, 2 * NA_KH - 1, 2 * NA_KW - 1), 0.5),
        "w_fourier": nrm(ks[7], (DEPTH, FOURIER_GROUPS, HEAD_DIM, HEAD_DIM), HEAD_DIM ** -0.5),
        "mem_norm": gain(ks[8], (DEPTH, D_MODEL)),
        "w_mem_kv": nrm(ks[9], (DEPTH, D_MODEL, 2 * MEM_WIDTH), D_MODEL ** -0.5),
        "mem_q_norm": gain(ks[10], (DEPTH, HEAD_DIM)),
        "mem_k_norm": gain(ks[11], (DEPTH, HEAD_DIM)),
        "out_norm": gain(ks[12], (DEPTH, D_MIX)),
        "w_out": nrm(ks[13], (DEPTH, D_MIX, D_MODEL), D_MIX ** -0.5 * 0.5),
        "ffn_norm": gain(ks[14], (DEPTH, D_MODEL)),
        "w_gate": nrm(ks[15], (DEPTH, D_MODEL, D_FF), D_MODEL ** -0.5),
        "w_up": nrm(ks[16], (DEPTH, D_MODEL, D_FF), D_MODEL ** -0.5),
        "w_down": nrm(ks[17], (DEPTH, D_FF, D_MODEL), D_FF ** -0.5 * 0.5),
    }


def reference(x, mem, attn_norm, w_in, na_q_norm, na_k_norm, na_rpb, w_fourier,
              mem_norm, w_mem_kv, mem_q_norm, mem_k_norm, out_norm, w_out,
              ffn_norm, w_gate, w_up, w_down):
    B, S, _ = x.shape
    M = mem.shape[1]
    for l in range(DEPTH):
        h = rms_norm(x, attn_norm[l])
        proj = h @ w_in[l]
        o1 = NA_WIDTH
        o2 = 2 * NA_WIDTH
        o3 = 3 * NA_WIDTH
        o4 = o3 + FOURIER_WIDTH
        q_na = rms_norm(proj[..., :o1].reshape(B, S, NA_HEADS, HEAD_DIM), na_q_norm[l])
        k_na = rms_norm(proj[..., o1:o2].reshape(B, S, NA_HEADS, HEAD_DIM), na_k_norm[l])
        v_na = proj[..., o2:o3].reshape(B, S, NA_HEADS, HEAD_DIM)
        u_f = proj[..., o3:o4]
        q_m = rms_norm(proj[..., o4:].reshape(B, S, MEM_HEADS, HEAD_DIM), mem_q_norm[l])

        mem_n = rms_norm(mem, mem_norm[l])
        kv_m = mem_n @ w_mem_kv[l]
        k_m = rms_norm(kv_m[..., :MEM_WIDTH].reshape(B, M, MEM_HEADS, HEAD_DIM), mem_k_norm[l])
        v_m = kv_m[..., MEM_WIDTH:].reshape(B, M, MEM_HEADS, HEAD_DIM)

        y_na = neighbourhood_attention(q_na, k_na, v_na, na_rpb[l])
        y_f = fourier_mix(u_f, w_fourier[l])
        y_m = memory_attention(q_m, k_m, v_m)

        y = jnp.concatenate([y_na, y_f, y_m], axis=-1)
        y = rms_norm(y.reshape(B, S, D_MIX // HEAD_DIM, HEAD_DIM),
                     jnp.ones((HEAD_DIM,), x.dtype)).reshape(B, S, D_MIX) * out_norm[l]
        x = x + y @ w_out[l]

        h = rms_norm(x, ffn_norm[l])
        x = x + (jax.nn.silu(h @ w_gate[l]) * (h @ w_up[l])) @ w_down[l]
    return x
```

```cpp
#include <hip/hip_runtime.h>
#include <hip/hip_cooperative_groups.h>
#include <cstdio>
#include <cstdint>
namespace cg = cooperative_groups;
namespace pg8 {
#define PG8_LAS __attribute__((address_space(3)))
typedef unsigned short bf16_t;
typedef short bf16x8 __attribute__((ext_vector_type(8)));
typedef float f32x4 __attribute__((ext_vector_type(4)));
typedef unsigned u32x4 __attribute__((ext_vector_type(4)));
constexpr int BM = 256, BK = 64, HALF = 128, HTB = HALF * BK * 2  , STAGE_BYTES = 8 * HTB, NXCD = 8, WGM = 4;

__host__ __device__ __forceinline__ int lds_byte(int r, int c) { const int st = (r >> 4) * 2 + (c >> 5), rr = r & 15, cc = c & 31, ob = rr * 64 + cc * 2; return st * 1024 + (ob ^ (((ob >> 9) & 1) << 5)); }
__host__ __device__ __forceinline__ void stage_rc(int b, int& R, int& C) { const int st = b / 1024, sb = b % 1024, swz = sb ^ (((sb >> 9) & 1) << 5); R = (st >> 1) * 16 + swz / 64; C = (st & 1) * 32 + (swz % 64) / 2; }
__host__ __device__ __forceinline__ int perm32(int rho) { const int n = rho >> 4, i = rho & 15; return 8 * (i >> 2) + 4 * n + (i & 3); }

struct Unit { int pm, pn; };
struct Gemm { const bf16_t* A; const bf16_t* Bt; int M, N, K; };

struct StaticOrder {
    int nM, nN, nwg, G, c;
    __host__ __device__ void init(int M, int N, int G_, int c_) { nM = M / BM; nN = N / BM; nwg = nM * nN; G = G_; c = c_; }
    __host__ __device__ bool next(int i, Unit& u) const {
        const long L = (long)i * G + c; if (L >= nwg) return false;
        int wgid = (int)L; { const int q = nwg / NXCD, r = nwg % NXCD, xcd = wgid % NXCD, off = wgid / NXCD; wgid = (xcd < r ? xcd * (q + 1) : r * (q + 1) + (xcd - r) * q) + off; }
        const int nig = WGM * nN, gid = wgid / nig, fm = gid * WGM, gsz = (nM - fm) < WGM ? (nM - fm) : WGM;
        u.pm = fm + ((wgid % nig) % gsz); u.pn = (wgid % nig) / gsz; return true;
    }
    __device__ __forceinline__ void a_ready(const Unit&) const {}
    __device__ __forceinline__ void done(const Unit&) const {}
};


typedef unsigned u32x4 __attribute__((ext_vector_type(4)));
__device__ __forceinline__ unsigned cvt_pk_bf16(float lo, float hi) { unsigned r; asm volatile("v_cvt_pk_bf16_f32 %0, %1, %2" : "=v"(r) : "v"(lo), "v"(hi)); return r; }
__device__ __forceinline__ u32x4 pack8(const f32x4 v0, const f32x4 v1) { u32x4 w; w.x = cvt_pk_bf16(v0[0], v0[1]); w.y = cvt_pk_bf16(v0[2], v0[3]); w.z = cvt_pk_bf16(v1[0], v1[1]); w.w = cvt_pk_bf16(v1[2], v1[3]); return w; }
__device__ __forceinline__ float sq4(const f32x4 v) { return (v[0] * v[0] + v[1] * v[1]) + (v[2] * v[2] + v[3] * v[3]); }
__device__ __forceinline__ float sum_x32(float v) { const auto r = __builtin_amdgcn_permlane32_swap(__builtin_bit_cast(unsigned, v), __builtin_bit_cast(unsigned, v), false, false); return __builtin_bit_cast(float, r[0]) + __builtin_bit_cast(float, r[1]); }
__device__ __forceinline__ float max_x32(float v) { const auto r = __builtin_amdgcn_permlane32_swap(__builtin_bit_cast(unsigned, v), __builtin_bit_cast(unsigned, v), false, false); return fmaxf(__builtin_bit_cast(float, r[0]), __builtin_bit_cast(float, r[1])); }
__device__ __forceinline__ float sum_fq(float v) { v += __shfl_xor(v, 16); v += __shfl_xor(v, 32); return v; }
__device__ __forceinline__ float max_fq(float v) { v = fmaxf(v, __shfl_xor(v, 16)); v = fmaxf(v, __shfl_xor(v, 32)); return v; }
constexpr float RMS_EPS = 1e-6f;

struct EpiProj {
    static constexpr bool PERM = true, AFTER_DRAIN = false;
    bf16_t* O; int ldc; const float* ssrow; float rdim_inv; float* ssh; int hs_stride; int h_lo, h_hi;
    bf16_t* KB; int kb_lo, kb_hi;
    __device__ __forceinline__ void operator()(const f32x4 (&acc)[2][2][4][2], const Unit& u, int wr, int wc, int fr, int fq) const {
        const int row0 = u.pm * BM + wr * 64 + fr, col0 = u.pn * BM + wc * 32 + 8 * fq;
        const bool heads = (ssh != nullptr) && u.pn >= h_lo && u.pn < h_hi;
        const int hbase = 2 * (u.pn - h_lo);
#pragma unroll
        for (int ai = 0; ai < 2; ++ai)
#pragma unroll
            for (int m = 0; m < 4; ++m) {
                const int row = row0 + ai * HALF + m * 16;
                float r = 1.f; if (ssrow) r = __builtin_amdgcn_rsqf(ssrow[row] * rdim_inv + RMS_EPS);
#pragma unroll
                for (int bj = 0; bj < 2; ++bj) {
                    const f32x4 v0 = acc[ai][bj][m][0] * r, v1 = acc[ai][bj][m][1] * r;
                    if (u.pn >= kb_lo && u.pn < kb_hi) { const int hh = 2 * (u.pn - kb_lo) + bj, dc = (wc * 32 + 8 * fq) >> 3;
                        *(u32x4*)(KB + ((((size_t)(row >> 6) * 8 + hh) * 8 + ((row & 63) >> 3)) * 16 + dc) * 64 + (row & 7) * 8) = pack8(v0, v1); }
                    else *(u32x4*)(O + (size_t)row * ldc + col0 + bj * HALF) = pack8(v0, v1);
                    if (heads) { float s = sq4(v0) + sq4(v1); s = sum_fq(s); if (fq == 0) atomicAdd(ssh + (size_t)(hbase + bj) * hs_stride + row, s); }
                }
            }
    }
};
struct EpiColScale {
    static constexpr bool PERM = true, AFTER_DRAIN = false;
    bf16_t* O; int tb_shift; int nh; const float* sscol; float rdim_inv;
    __device__ __forceinline__ void operator()(const f32x4 (&acc)[2][2][4][2], const Unit& u, int wr, int wc, int fr, int fq) const {
        typedef unsigned u32x2e __attribute__((ext_vector_type(2)));
        const int row0 = u.pm * BM + wr * 64 + fr, col0 = u.pn * BM + wc * 32 + 8 * fq;
        f32x4 rc[2][2];
#pragma unroll
        for (int bj = 0; bj < 2; ++bj)
#pragma unroll
            for (int n = 0; n < 2; ++n) {
                float one = 1.f; asm volatile("" : "+v"(one));
                rc[bj][n] = (f32x4){one, one, one, one};
                if (sscol) { const f32x4 s = *(const f32x4*)(sscol + col0 + bj * HALF + 4 * n);
#pragma unroll
                    for (int i = 0; i < 4; ++i) rc[bj][n][i] = __builtin_amdgcn_rsqf(s[i] * rdim_inv + RMS_EPS); }
            }
#pragma unroll
        for (int ai = 0; ai < 2; ++ai)
#pragma unroll
            for (int m = 0; m < 4; ++m) {
                const int row = row0 + ai * HALF + m * 16, h = row >> 7, d = row & 127;
#pragma unroll
                for (int bj = 0; bj < 2; ++bj) {
                    const int col = col0 + bj * HALF, blk = col >> tb_shift, kg = (col & ((1 << tb_shift) - 1)) >> 2;
                    const size_t e = ((size_t)(blk * nh + h) * (size_t)(1 << (tb_shift - 2)) + kg) * 512 + d * 4;
                    const u32x4 w = pack8(acc[ai][bj][m][0] * rc[bj][0], acc[ai][bj][m][1] * rc[bj][1]);
                    *(u32x2e*)(O + e) = (u32x2e){w.x, w.y}; *(u32x2e*)(O + e + 512) = (u32x2e){w.z, w.w};
                }
            }
    }
};
struct EpiResid {
    static constexpr bool PERM = true, AFTER_DRAIN = false;
    bf16_t* xb; float* xout; float* ssnext; int ldc;
    __device__ __forceinline__ void operator()(const f32x4 (&acc)[2][2][4][2], const Unit& u, int wr, int wc, int fr, int fq) const {
        const int row0 = u.pm * BM + wr * 64 + fr, col0 = u.pn * BM + wc * 32 + 8 * fq;
#pragma unroll
        for (int ai = 0; ai < 2; ++ai) {
            u32x4 res[4][2];
#pragma unroll
            for (int m = 0; m < 4; ++m)
#pragma unroll
                for (int bj = 0; bj < 2; ++bj) res[m][bj] = *(const u32x4*)(xb + (size_t)(row0 + ai * HALF + m * 16) * ldc + col0 + bj * HALF);
            __builtin_amdgcn_sched_barrier(0);
#pragma unroll
            for (int m = 0; m < 4; ++m) {
                const int row = row0 + ai * HALF + m * 16; float s = 0.f;
#pragma unroll
                for (int bj = 0; bj < 2; ++bj) {
                    const size_t p = (size_t)row * ldc + col0 + bj * HALF; const u32x4 rw = res[m][bj];
                    const f32x4 r0 = (f32x4){__builtin_bit_cast(float, rw.x << 16), __builtin_bit_cast(float, rw.x & 0xffff0000u), __builtin_bit_cast(float, rw.y << 16), __builtin_bit_cast(float, rw.y & 0xffff0000u)};
                    const f32x4 r1 = (f32x4){__builtin_bit_cast(float, rw.z << 16), __builtin_bit_cast(float, rw.z & 0xffff0000u), __builtin_bit_cast(float, rw.w << 16), __builtin_bit_cast(float, rw.w & 0xffff0000u)};
                    const f32x4 v0 = acc[ai][bj][m][0] + r0, v1 = acc[ai][bj][m][1] + r1;
                    if (xout) { *(f32x4*)(xout + p) = v0; *(f32x4*)(xout + p + 4) = v1; }
                    else { *(u32x4*)(xb + p) = pack8(v0, v1); s += sq4(v0) + sq4(v1); }
                }
                if (!xout) { s = sum_fq(s); if (fq == 0) atomicAdd(ssnext + row, s); }
            }
            asm volatile("" ::: "memory");
        }
    }
};
struct EpiSwiGLU {
    static constexpr bool PERM = true, AFTER_DRAIN = false;
    bf16_t* H; int ldh; const float* ssrow; float rdim_inv;
    __device__ __forceinline__ void operator()(const f32x4 (&acc)[2][2][4][2], const Unit& u, int wr, int wc, int fr, int fq) const {
        const int row0 = u.pm * BM + wr * 64 + fr, col0 = u.pn * HALF + wc * 32 + 8 * fq;
#pragma unroll
        for (int ai = 0; ai < 2; ++ai)
#pragma unroll
            for (int m = 0; m < 4; ++m) {
                const int row = row0 + ai * HALF + m * 16;
                const float r = __builtin_amdgcn_rsqf(ssrow[row] * rdim_inv + RMS_EPS);
                f32x4 h[2];
#pragma unroll
                for (int n = 0; n < 2; ++n) {
                    const f32x4 g = acc[ai][0][m][n] * r, up = acc[ai][1][m][n] * r;
#pragma unroll
                    for (int i = 0; i < 4; ++i) h[n][i] = g[i] * __builtin_amdgcn_rcpf(1.f + __expf(-g[i])) * up[i];
                }
                *(u32x4*)(H + (size_t)row * ldh + col0) = pack8(h[0], h[1]);
            }
    }
};
template <class Epi, class Sched, bool ALIGN_EPI = false, bool SP2 = false>
__device__ __forceinline__ void gemm_phase(PG8_LAS unsigned char* lds, const Gemm g, const Sched& S, const Epi& E, const int wave_in) {
    int tid_l; asm volatile("v_mbcnt_lo_u32_b32 %0, -1, 0\n\tv_mbcnt_hi_u32_b32 %0, -1, %0" : "=v"(tid_l)); tid_l += wave_in * 64;
    const int tid = tid_l, wid = __builtin_amdgcn_readfirstlane(tid >> 6), lane = tid & 63, wr = wid >> 2, wc = wid & 3, fr = lane & 15, fq = lane >> 4;
    const int K = g.K, nt = K / BK;
    unsigned voffA[2], voffB[2];
#pragma unroll
    for (int i = 0; i < 2; ++i) { int R, C; stage_rc(tid * 16 + i * 8192, R, C); const int Rb = Epi::PERM ? ((R & ~31) + perm32(R & 31)) : R;
        voffA[i] = (unsigned)(R * K + C) * 2u; voffB[i] = (unsigned)(Rb * K + C) * 2u; }
    const size_t kstep = (size_t)(BK * 2);
    const size_t hstep = (size_t)HALF * K * 2;
    const size_t tstep = 2 * hstep;
    const unsigned ldsw = (unsigned)wid * 1024u;
    const int aoff = lds_byte(wr * 64 + fr, fq * 8), boff = lds_byte(wc * 32 + fr, fq * 8);
#define PG8_SA(b, h) (((b) * 2 + (h)) * HTB)
#define PG8_SB(b, h) ((4 + (b) * 2 + (h)) * HTB)
#define PG8_STAGE(bufoff, gbase, voff) do { _Pragma("unroll") for (int _i = 0; _i < 2; ++_i) \
        __builtin_amdgcn_global_load_lds((const unsigned*)((const char*)(gbase) + (voff)[_i]), (PG8_LAS unsigned*)(lds + (bufoff) + ldsw + _i * 8192), 16, 0, 0); } while (0)
#define PG8_LDA(dst, b, h) do { _Pragma("unroll") for (int m = 0; m < 4; ++m) _Pragma("unroll") for (int k = 0; k < 2; ++k) dst[m][k] = *(const PG8_LAS bf16x8*)(lds + PG8_SA(b, h) + aoff + m * 2048 + k * 1024); } while (0)
#define PG8_LDB(dst, b, h) do { _Pragma("unroll") for (int n = 0; n < 2; ++n) _Pragma("unroll") for (int k = 0; k < 2; ++k) dst[n][k] = *(const PG8_LAS bf16x8*)(lds + PG8_SB(b, h) + boff + n * 2048 + k * 1024); } while (0)
#define PG8_MMA(ai, bj, At, Bt) do { __builtin_amdgcn_s_setprio(1); _Pragma("unroll") for (int m = 0; m < 4; ++m) _Pragma("unroll") for (int n = 0; n < 2; ++n) _Pragma("unroll") for (int k = 0; k < 2; ++k) \
        acc[ai][bj][m][n] = __builtin_amdgcn_mfma_f32_16x16x32_bf16(Bt[n][k], At[m][k], acc[ai][bj][m][n], 0, 0, 0); __builtin_amdgcn_s_setprio(0); } while (0)
#define PG8_WAIT_V(n) asm volatile("s_waitcnt vmcnt(" #n ")" ::: "memory")
#define PG8_WAIT_L(n) asm volatile("s_waitcnt lgkmcnt(" #n ")" ::: "memory")
#define PG8_BAR __builtin_amdgcn_s_barrier()
#define PG8_SCHED __builtin_amdgcn_sched_barrier(0)
    Unit cur, nxt; int ui = 0;
    if (!S.next(0, cur)) return;
    f32x4 acc[2][2][4][2];
#pragma unroll
    for (int a = 0; a < 2; ++a)
#pragma unroll
        for (int b = 0; b < 2; ++b)
#pragma unroll
            for (int m = 0; m < 4; ++m)
#pragma unroll
                for (int n = 0; n < 2; ++n) acc[a][b][m][n] = (f32x4){0.f, 0.f, 0.f, 0.f};
    bf16x8 At[4][2], B0[2][2], B1[2][2];
    const char* cA = (const char*)g.A + (size_t)cur.pm * tstep; const char* cB = (const char*)g.Bt + (size_t)cur.pn * tstep;
    S.a_ready(cur);
    if constexpr (SP2) {
        PG8_STAGE(PG8_SB(0, 0), cB, voffB); PG8_STAGE(PG8_SB(0, 1), cB + hstep, voffB); PG8_STAGE(PG8_SA(0, 0), cA, voffA); PG8_STAGE(PG8_SA(0, 1), cA + hstep, voffA);
        if (wr == 1) PG8_BAR;
        PG8_WAIT_V(2); PG8_BAR;
        PG8_STAGE(PG8_SB(1, 0), cB + kstep, voffB); PG8_STAGE(PG8_SA(1, 0), cA + kstep, voffA); PG8_STAGE(PG8_SB(1, 1), cB + hstep + kstep, voffB);
        PG8_WAIT_V(6); PG8_BAR;
    } else {
        PG8_STAGE(PG8_SB(0, 0), cB, voffB); PG8_STAGE(PG8_SA(0, 0), cA, voffA); PG8_STAGE(PG8_SB(0, 1), cB + hstep, voffB); PG8_STAGE(PG8_SA(0, 1), cA + hstep, voffA);
        if (wr == 1) PG8_BAR;
        PG8_WAIT_V(4); PG8_BAR;
        PG8_STAGE(PG8_SB(1, 0), cB + kstep, voffB); PG8_STAGE(PG8_SA(1, 0), cA + kstep, voffA); PG8_STAGE(PG8_SB(1, 1), cB + hstep + kstep, voffB);
        PG8_WAIT_V(6); PG8_BAR;
    }
    for (;;) {
        const bool has_next = S.next(ui + 1, nxt);
        const char* nA = has_next ? (const char*)g.A + (size_t)nxt.pm * tstep : cA; const char* nB = has_next ? (const char*)g.Bt + (size_t)nxt.pn * tstep : cB;
        for (int t = 0; t < nt; t += 2) {
            const bool last = (t == nt - 2);
            const char* a1 = cA + (size_t)(t + 1) * kstep;
            const char* a2 = last ? nA : cA + (size_t)(t + 2) * kstep; const char* b2 = last ? nB : cB + (size_t)(t + 2) * kstep;
            const char* a3 = a2 + kstep; const char* b3 = b2 + kstep;
            if (last && has_next) S.a_ready(nxt);
            if constexpr (SP2) {
            PG8_LDB(B0, 0, 0); PG8_LDB(B1, 0, 1); PG8_SCHED; PG8_LDA(At, 0, 0); PG8_STAGE(PG8_SA(1, 1), a1 + hstep, voffA);
            PG8_WAIT_V(8); PG8_WAIT_L(0); PG8_BAR; PG8_MMA(0, 0, At, B0); PG8_MMA(0, 1, At, B1); PG8_BAR; PG8_SCHED;
            PG8_LDA(At, 0, 1); PG8_STAGE(PG8_SB(0, 0), b2, voffB); PG8_STAGE(PG8_SB(0, 1), b2 + hstep, voffB); PG8_STAGE(PG8_SA(0, 0), a2, voffA);
            PG8_WAIT_V(8); PG8_WAIT_L(0); PG8_BAR; PG8_MMA(1, 0, At, B0); PG8_MMA(1, 1, At, B1); PG8_BAR; PG8_SCHED;
            PG8_LDB(B0, 1, 0); PG8_LDB(B1, 1, 1); PG8_SCHED; PG8_LDA(At, 1, 0); PG8_STAGE(PG8_SA(0, 1), a2 + hstep, voffA);
            PG8_WAIT_V(8); PG8_WAIT_L(0); PG8_BAR; PG8_MMA(0, 0, At, B0); PG8_MMA(0, 1, At, B1); PG8_BAR; PG8_SCHED;
            PG8_LDA(At, 1, 1); PG8_STAGE(PG8_SB(1, 0), b3, voffB); PG8_STAGE(PG8_SB(1, 1), b3 + hstep, voffB); PG8_STAGE(PG8_SA(1, 0), a3, voffA);
            PG8_WAIT_V(8); PG8_WAIT_L(0); PG8_BAR; PG8_MMA(1, 0, At, B0); PG8_MMA(1, 1, At, B1); PG8_BAR; PG8_SCHED;
            } else {
            PG8_LDB(B0, 0, 0); PG8_SCHED; PG8_LDA(At, 0, 0); PG8_STAGE(PG8_SA(1, 1), a1 + hstep, voffA);
            PG8_WAIT_L(8); PG8_BAR; PG8_WAIT_L(0); PG8_MMA(0, 0, At, B0); PG8_BAR; PG8_SCHED;
            PG8_LDB(B1, 0, 1); PG8_STAGE(PG8_SB(0, 0), b2, voffB);
            PG8_BAR; PG8_WAIT_L(0); PG8_MMA(0, 1, At, B1); PG8_BAR;
            PG8_LDA(At, 0, 1); PG8_STAGE(PG8_SA(0, 0), a2, voffA);
            PG8_BAR; PG8_WAIT_L(0); PG8_MMA(1, 0, At, B0); PG8_BAR; PG8_SCHED;
            PG8_STAGE(PG8_SB(0, 1), b2 + hstep, voffB);
            PG8_WAIT_V(6); PG8_BAR; PG8_MMA(1, 1, At, B1); PG8_BAR;
            PG8_LDB(B0, 1, 0); PG8_SCHED; PG8_LDA(At, 1, 0); PG8_STAGE(PG8_SA(0, 1), a2 + hstep, voffA);
            PG8_WAIT_L(8); PG8_BAR; PG8_WAIT_L(0); PG8_MMA(0, 0, At, B0); PG8_BAR; PG8_SCHED;
            PG8_LDB(B1, 1, 1); PG8_STAGE(PG8_SB(1, 0), b3, voffB);
            PG8_BAR; PG8_WAIT_L(0); PG8_MMA(0, 1, At, B1); PG8_BAR;
            PG8_LDA(At, 1, 1); PG8_STAGE(PG8_SA(1, 0), a3, voffA);
            PG8_BAR; PG8_WAIT_L(0); PG8_MMA(1, 0, At, B0); PG8_BAR; PG8_SCHED;
            PG8_STAGE(PG8_SB(1, 1), b3 + hstep, voffB);
            PG8_WAIT_V(6); PG8_BAR; PG8_MMA(1, 1, At, B1); PG8_BAR;
            }
        }
        if constexpr (ALIGN_EPI) { if (wr == 0) PG8_BAR; }
        if constexpr (!Epi::AFTER_DRAIN) { E(acc, cur, wr, wc, fr, fq); S.done(cur); }
        if (!has_next) break;
#pragma unroll
        for (int a = 0; a < 2; ++a)
#pragma unroll
            for (int b = 0; b < 2; ++b)
#pragma unroll
                for (int m = 0; m < 4; ++m)
#pragma unroll
                    for (int n = 0; n < 2; ++n) acc[a][b][m][n] = (f32x4){0.f, 0.f, 0.f, 0.f};
        cur = nxt; cA = nA; cB = nB; ++ui;
        if constexpr (ALIGN_EPI) { if (wr == 1) PG8_BAR; }
    }
    PG8_WAIT_V(0);
    if constexpr (!ALIGN_EPI) { if (wr == 0) PG8_BAR; }
    PG8_BAR;
    if constexpr (Epi::AFTER_DRAIN) { E.fused(acc, cur, wr, wc, fr, fq, lds, wid, lane); S.done(cur); }
#undef PG8_SA
#undef PG8_SB
#undef PG8_STAGE
#undef PG8_LDA
#undef PG8_LDB
#undef PG8_MMA
#undef PG8_WAIT_V
#undef PG8_WAIT_L
#undef PG8_BAR
#undef PG8_SCHED
}
}

#ifndef PG8_SP2
#define PG8_SP2 true
#endif
#ifndef PG8_ALIGN
#define PG8_ALIGN true
#endif
#ifndef NPRO
#define NPRO 1
#endif
#ifndef LSEQ
#define LSEQ 0x543210ull
#define LSEQ_N 6
#endif
#ifndef MK_LAUNCHES
#define MK_LAUNCHES 1
#endif

using pg8::bf16_t; using pg8::bf16x8; using pg8::f32x4; using pg8::u32x4;
typedef unsigned u32x2 __attribute__((ext_vector_type(2)));
#define GAS __attribute__((address_space(1)))
#define LAS __attribute__((address_space(3)))
constexpr int NWAVES = 8;
constexpr int BATCH = 4, SEQ = 8192, DM = 2048, NTOK = BATCH * SEQ, DIN = 4096, DFF = 5632, NMEM = 256, HD = 128;
constexpr int PROJ_W = 3072;
constexpr int NPH = NPRO + 2 * LSEQ_N;
constexpr float EPS = 1e-6f;
constexpr float ATT_SCALE = 0.08838834764831845f;

constexpr size_t MiB = 1u << 20;
constexpr size_t WS_SS = 1 * MiB;
constexpr size_t SS_X = 0, SS_H = 5 * (size_t)NTOK, SS_MK = SS_H + 2 * 20 * (size_t)NTOK, SS_END = SS_MK + 2 * 4 * 1024;
constexpr size_t WS_TAB = 9 * MiB;
constexpr size_t TAB_T64 = 0, TAB_T128 = 16 * 1024, TAB_MT = 128 * 1024, TAB_GQK = 768 * 1024, TAB_RPB = 800 * 1024;
constexpr size_t WS_WIN = 10 * MiB, WS_WOUT = 42 * MiB, WS_WGU = 58 * MiB, WS_WDN = 146 * MiB, WS_WMKV = 190 * MiB;
constexpr size_t WS_MEMB = 198 * MiB, WS_KM = 202 * MiB, WS_VMT = 204 * MiB, WS_XB = 206 * MiB;
constexpr size_t WS_PROJ = 334 * MiB, WS_VT = 526 * MiB, WS_Y = 590 * MiB, WS_A2 = 718 * MiB, WS_H = 334 * MiB, WS_KB = 782 * MiB, WS_END = 846 * MiB;
static_assert(SS_END * 4 <= 8 * MiB, "ss region");
static_assert(WS_H + (size_t)NTOK * DFF * 2 <= WS_A2, "hidden overlays proj | VT | y only");

constexpr int RING_BYTES = 131072, LDS_BYTES = 147456;

__device__ __forceinline__ float wave_sum(float v) {
#pragma unroll
    for (int o = 1; o < 64; o <<= 1) v += __shfl_xor(v, o);
    return v;
}
__device__ __forceinline__ float bf2f(unsigned short b) { return __builtin_bit_cast(float, (unsigned)b << 16); }
__device__ __forceinline__ float cos_rev(float x) { return __builtin_amdgcn_cosf(x); }
__device__ __forceinline__ float sin_rev(float x) { return __builtin_amdgcn_sinf(x); }
#define MFMA16(a, b, c) __builtin_amdgcn_mfma_f32_16x16x32_bf16((a), (b), (c), 0, 0, 0)
#define CFENCE() asm volatile("" ::: "memory")

struct Args { const float* in[18]; float* out; unsigned char* ws; int ph_lo, ph_hi; };

struct TrItem { const float* W; const float* gain; bf16_t* WT; int N, K, k0, n0, drow; };
__device__ __forceinline__ TrItem tr_decode(const Args& a, unsigned char* ws, int it) {
    constexpr int I_IN = 32 * 128, I_OUT = 32 * 64, I_G = 32 * 176, I_D = 88 * 64, I_MKV = 32 * 32, I_L = I_IN + I_OUT + 2 * I_G + I_D + I_MKV;
    const int l = it / I_L; int r = it % I_L; TrItem d;
    if (r < I_IN) { const int kb = r / 128, nb = r % 128, n0 = 32 * nb;
        d.W = a.in[3] + (size_t)l * DM * DIN; d.gain = a.in[2] + l * DM; d.WT = (bf16_t*)(ws + WS_WIN) + (size_t)l * DIN * DM; d.N = DIN; d.K = DM; d.k0 = 64 * kb; d.n0 = n0;
        d.drow = n0 + ((n0 < 2048) ? 0 : (n0 < 3072 ? 1024 : -1024)); return d; }
    r -= I_IN;
    if (r < I_OUT) { const int kb = r / 64, nb = r % 64;
        d.W = a.in[13] + (size_t)l * DM * DM; d.gain = a.in[12] + l * DM; d.WT = (bf16_t*)(ws + WS_WOUT) + (size_t)l * DM * DM; d.N = DM; d.K = DM; d.k0 = 64 * kb; d.n0 = 32 * nb; d.drow = 32 * nb; return d; }
    r -= I_OUT;
    if (r < 2 * I_G) { const int up = r >= I_G; if (up) r -= I_G; const int kb = r / 176, nb = r % 176, n0 = 32 * nb;
        d.W = a.in[up ? 16 : 15] + (size_t)l * DM * DFF; d.gain = a.in[14] + l * DM; d.WT = (bf16_t*)(ws + WS_WGU) + (size_t)l * 2 * DFF * DM; d.N = DFF; d.K = DM; d.k0 = 64 * kb; d.n0 = n0;
        d.drow = (n0 >> 7) * 256 + (n0 & 127) + (up ? 128 : 0); return d; }
    r -= 2 * I_G;
    if (r < I_D) { const int kb = r / 64, nb = r % 64;
        d.W = a.in[17] + (size_t)l * DFF * DM; d.gain = nullptr; d.WT = (bf16_t*)(ws + WS_WDN) + (size_t)l * DM * DFF; d.N = DM; d.K = DFF; d.k0 = 64 * kb; d.n0 = 32 * nb; d.drow = 32 * nb; return d; }
    r -= I_D;
    { const int kb = r / 32, nb = r % 32;
        d.W = a.in[9] + (size_t)l * DM * 1024; d.gain = a.in[8] + l * DM; d.WT = (bf16_t*)(ws + WS_WMKV) + (size_t)l * 1024 * DM; d.N = 1024; d.K = DM; d.k0 = 64 * kb; d.n0 = 32 * nb; d.drow = 32 * nb; return d; }
}
__device__ __forceinline__ void tr_load(const TrItem& d, float (&v)[32], int lane) {
    const float* src = d.W + (size_t)(d.k0 + (lane >> 5)) * d.N + d.n0 + (lane & 31);
#pragma unroll
    for (int i = 0; i < 32; ++i) v[i] = src[(size_t)(2 * i) * d.N];
}
__device__ __forceinline__ void tr_store(const TrItem& d, const float (&v)[32], LAS float* scr, int lane) {
#pragma unroll
    for (int i = 0; i < 32; ++i) { const int kk = 2 * i + (lane >> 5); const float gk = d.gain ? d.gain[d.k0 + kk] : 1.f; scr[kk * 33 + (lane & 31)] = v[i] * gk; }
    asm volatile("s_waitcnt lgkmcnt(0)" ::: "memory");
    const int c = lane & 7;
#pragma unroll
    for (int j = 0; j < 4; ++j) { const int n = (lane >> 3) + 8 * j; const LAS float* s = scr + (8 * c) * 33 + n;
        u32x4 o; o.x = pg8::cvt_pk_bf16(s[0 * 33], s[1 * 33]); o.y = pg8::cvt_pk_bf16(s[2 * 33], s[3 * 33]); o.z = pg8::cvt_pk_bf16(s[4 * 33], s[5 * 33]); o.w = pg8::cvt_pk_bf16(s[6 * 33], s[7 * 33]);
        *(u32x4*)(d.WT + (size_t)(d.drow + n) * d.K + d.k0 + 8 * c) = o; }
    asm volatile("s_waitcnt lgkmcnt(0)" ::: "memory");
}

__device__ __forceinline__ void prologue(const Args& a, unsigned char* ws, LAS unsigned char* lds, int tid, int lane, int wave, int vcu, int G) {
    LAS float* scr = (LAS float*)(lds + wave * 16384);
    const int gw = vcu * NWAVES + wave, NGW = G * NWAVES;
    constexpr int N_ITEMS = 2 * (32 * 128 + 32 * 64 + 2 * 32 * 176 + 88 * 64 + 32 * 32);
    if (gw < N_ITEMS) {
        float cur[32], nxt[32];
        TrItem dc = tr_decode(a, ws, gw);
        tr_load(dc, cur, lane);
#pragma unroll 1
        for (int it = gw; it < N_ITEMS; it += NGW) {
            const int itn = it + NGW; const bool more = itn < N_ITEMS;
            TrItem dn = tr_decode(a, ws, more ? itn : it);
            if (more) tr_load(dn, nxt, lane);
            tr_store(dc, cur, scr, lane);
#pragma unroll
            for (int i = 0; i < 32; ++i) cur[i] = nxt[i];
            dc = dn;
        }
    }
    float* ss = (float*)(ws + WS_SS);
    for (int m = gw; m < NTOK + BATCH * NMEM; m += NGW) {
        const bool ismem = m >= NTOK; const int row = ismem ? m - NTOK : m;
        const f32x4* xr = (const f32x4*)((ismem ? a.in[1] : a.in[0]) + (size_t)row * DM) + lane;
        f32x4 v[8]; float s = 0.f;
#pragma unroll
        for (int j = 0; j < 8; ++j) { v[j] = xr[64 * j]; s += pg8::sq4(v[j]); }
        s = wave_sum(s);
        float sc = 1.f;
        if (ismem) sc = __builtin_amdgcn_rsqf(s * (1.f / DM) + EPS); else if (lane == 0) ss[SS_X + row] = s;
        u32x2* o = (u32x2*)((bf16_t*)(ws + (ismem ? WS_MEMB : WS_XB)) + (size_t)row * DM) + lane;
#pragma unroll
        for (int j = 0; j < 8; ++j) { u32x2 w; w.x = pg8::cvt_pk_bf16(v[j][0] * sc, v[j][1] * sc); w.y = pg8::cvt_pk_bf16(v[j][2] * sc, v[j][3] * sc); o[64 * j] = w; }
    }
    const int gt = vcu * (NWAVES * 64) + tid, NT = G * NWAVES * 64;
    { float z = 0.f; asm volatile("" : "+v"(z));
      for (size_t i = (size_t)NTOK / 4 + gt; i < SS_END / 4; i += NT) ((f32x4*)ss)[i] = (f32x4){z, z, z, z}; }
    bf16_t* T64 = (bf16_t*)(ws + WS_TAB + TAB_T64); bf16_t* T128 = (bf16_t*)(ws + WS_TAB + TAB_T128); bf16_t* MT = (bf16_t*)(ws + WS_TAB + TAB_MT); float* GQK = (float*)(ws + WS_TAB + TAB_GQK);
    for (int i = gt; i < 128 * 64; i += NT) { const int m = i >> 6, s1 = i & 63, k1 = m & 63; const float fr = (float)((k1 * s1) & 63) * (1.f / 64.f);
        const float v = (m < 64) ? cos_rev(fr) : -sin_rev(fr); T64[i] = (bf16_t)(pg8::cvt_pk_bf16(v, 0.f) & 0xffffu); }
    for (int i = gt; i < 3 * 128 * 128; i += NT) { const int p = i >> 14, k2 = (i >> 7) & 127, s2 = i & 127; const float fr = (float)((k2 * s2) & 127) * (1.f / 128.f);
        const float v = (p == 0) ? cos_rev(fr) : (p == 1 ? -sin_rev(fr) : sin_rev(fr)); T128[i] = (bf16_t)(pg8::cvt_pk_bf16(v, 0.f) & 0xffffu); }
    { float* RPB = (float*)(ws + WS_TAB + TAB_RPB); for (int i = gt; i < 2 * 8 * 15 * 31; i += NT) RPB[i] = a.in[6][i]; }
    for (int i = gt; i < 2 * 2 * 128; i += NT) { const int d = i & 127, kind = (i >> 7) & 1, l = i >> 8;
        GQK[i] = (kind == 0 ? a.in[4][l * HD + d] * a.in[5][l * HD + d] : a.in[10][l * HD + d] * a.in[11][l * HD + d]) * ATT_SCALE; }
    for (int i = gt; i < 2 * 4 * 256 * 128; i += NT) { const int e = i & 127, c2 = (i >> 7) & 255, lg = i >> 15, c = c2 & 127, im = c2 >> 7;
        const float* wf = a.in[7] + (size_t)lg * 128 * 128 + e; float acc = 0.f;
#pragma unroll 16
        for (int cp = 0; cp < 128; ++cp) { const float fr = (float)((c * cp) & 127) * (1.f / 128.f); const float t = im ? sin_rev(fr) : cos_rev(fr); acc += t * wf[cp * 128]; }
        MT[(((size_t)lg * 64 + (c2 >> 2)) * 128 + e) * 4 + (c2 & 3)] = (bf16_t)(pg8::cvt_pk_bf16(acc * (1.f / 1024.f), 0.f) & 0xffffu); }
}

typedef __amdgpu_buffer_rsrc_t rsrc_t;
__device__ __forceinline__ rsrc_t make_rsrc(void* p) { return __builtin_amdgcn_make_buffer_rsrc(p, 0, 0x7fffffff, 0x00020000); }
template <class T> __device__ __forceinline__ T bld(rsrc_t r, unsigned voff, unsigned soff) {
    if constexpr (sizeof(T) == 16) { const u32x4 v = __builtin_amdgcn_raw_buffer_load_b128(r, voff, soff, 0); return __builtin_bit_cast(T, v); }
    else if constexpr (sizeof(T) == 8) { const u32x2 v = __builtin_amdgcn_raw_buffer_load_b64(r, voff, soff, 0); return __builtin_bit_cast(T, v); }
    else if constexpr (sizeof(T) == 4) { const unsigned v = __builtin_amdgcn_raw_buffer_load_b32(r, voff, soff, 0); return __builtin_bit_cast(T, v); }
    else { const unsigned short v = __builtin_amdgcn_raw_buffer_load_b16(r, voff, soff, 0); return __builtin_bit_cast(T, v); }
}
template <class T> __device__ __forceinline__ void bst(rsrc_t r, unsigned voff, unsigned soff, T v) {
    if constexpr (sizeof(T) == 16) __builtin_amdgcn_raw_buffer_store_b128(__builtin_bit_cast(u32x4, v), r, voff, soff, 0);
    else if constexpr (sizeof(T) == 8) __builtin_amdgcn_raw_buffer_store_b64(__builtin_bit_cast(u32x2, v), r, voff, soff, 0);
    else if constexpr (sizeof(T) == 4) __builtin_amdgcn_raw_buffer_store_b32(__builtin_bit_cast(unsigned, v), r, voff, soff, 0);
    else __builtin_amdgcn_raw_buffer_store_b16(__builtin_bit_cast(unsigned short, v), r, voff, soff, 0);
}
#define SCHED_FENCE() __builtin_amdgcn_sched_barrier(0)
typedef short v4i16_t __attribute__((ext_vector_type(4)));
constexpr unsigned OFF_T64 = (unsigned)(WS_TAB + TAB_T64), OFF_T128 = (unsigned)(WS_TAB + TAB_T128), OFF_MT = (unsigned)(WS_TAB + TAB_MT), OFF_GQK = (unsigned)(WS_TAB + TAB_GQK), OFF_RPB = (unsigned)(WS_TAB + TAB_RPB);
constexpr unsigned OFF_PROJ = (unsigned)WS_PROJ, OFF_VT = (unsigned)WS_VT, OFF_Y = (unsigned)WS_Y, OFF_A2R = (unsigned)WS_A2, OFF_A2I = (unsigned)(WS_A2 + 32 * MiB), OFF_KM = (unsigned)WS_KM, OFF_VMT = (unsigned)WS_VMT, OFF_SS = (unsigned)WS_SS;

__device__ __forceinline__ void fourier_stage_a(rsrc_t R, int it, int lane) {
    const int bg = it >> 7, s2 = it & 127, b = bg >> 2, g = bg & 3, n = lane & 15, kq = lane >> 4;
    bf16x8 wA[8][2];
    { const unsigned wo = (unsigned)(n * 64 + 8 * kq) * 2u;
#pragma unroll
      for (int mt = 0; mt < 8; ++mt)
#pragma unroll
        for (int ks = 0; ks < 2; ++ks) wA[mt][ks] = bld<bf16x8>(R, wo, OFF_T64 + (16 * mt * 64 + 32 * ks) * 2); }
    float tcs[16], tsn[16];
#pragma unroll
    for (int q = 0; q < 16; ++q) { const int k1 = 16 * (q >> 2) + 4 * kq + (q & 3); const float fr = (float)((s2 * k1) & 8191) * (1.f / 8192.f); tcs[q] = cos_rev(fr); tsn[q] = sin_rev(fr); }
    const unsigned ub = OFF_PROJ + (unsigned)(((b * SEQ + s2) * PROJ_W + 2048 + g * HD) * 2);
    const unsigned uo = (unsigned)(2 * n + kq * (8 * 128 * PROJ_W)) * 2u;
    const unsigned so = (unsigned)(kq * 4 * 16384 + 2 * n) * 2u;
    const unsigned ab = (unsigned)((bg * 64 * 128 + s2) * 128) * 2u;
    unsigned cur[16], nxt[16];
#pragma unroll
    for (int q = 0; q < 16; ++q) cur[q] = bld<unsigned>(R, uo, ub + (unsigned)((32 * (q >> 3) + (q & 7)) * (128 * PROJ_W)) * 2u);
#pragma unroll 1
    for (int ctp = 0; ctp < 4; ++ctp) {
        const int ctn = ctp < 3 ? ctp + 1 : 3;
#pragma unroll
        for (int q = 0; q < 16; ++q) nxt[q] = bld<unsigned>(R, uo, ub + (unsigned)((32 * (q >> 3) + (q & 7)) * (128 * PROJ_W) + 32 * ctn) * 2u);
        SCHED_FENCE();
        bf16x8 be[2], bo[2];
#pragma unroll
        for (int q = 0; q < 16; ++q) { be[q >> 3][q & 7] = (short)(cur[q] & 0xffffu); bo[q >> 3][q & 7] = (short)(cur[q] >> 16); }
        f32x4 ae[8], ao[8];
#pragma unroll
        for (int mt = 0; mt < 8; ++mt) { ae[mt] = (f32x4){0.f, 0.f, 0.f, 0.f}; ao[mt] = (f32x4){0.f, 0.f, 0.f, 0.f};
#pragma unroll
            for (int ks = 0; ks < 2; ++ks) { ae[mt] = MFMA16(wA[mt][ks], be[ks], ae[mt]); ao[mt] = MFMA16(wA[mt][ks], bo[ks], ao[mt]); } }
#pragma unroll
        for (int mt = 0; mt < 4; ++mt)
#pragma unroll
            for (int j = 0; j < 4; ++j) {
                const float cs = tcs[mt * 4 + j], sn = tsn[mt * 4 + j];
                const float ree = ae[mt][j], ime = ae[mt + 4][j], reo = ao[mt][j], imo = ao[mt + 4][j];
                const unsigned wr = pg8::cvt_pk_bf16(ree * cs + ime * sn, reo * cs + imo * sn);
                const unsigned wi = pg8::cvt_pk_bf16(ime * cs - ree * sn, imo * cs - reo * sn);
                const unsigned o = ab + (unsigned)((16 * mt + j) * 16384 + 32 * ctp) * 2u;
                bst<unsigned>(R, so, OFF_A2R + o, wr); bst<unsigned>(R, so, OFF_A2I + o, wi);
            }
        SCHED_FENCE();
#pragma unroll
        for (int q = 0; q < 16; ++q) cur[q] = nxt[q];
    }
}

constexpr int SLAB_ROWB = 288, SLAB_PLANE = 128 * SLAB_ROWB, MT_LDS = 2 * SLAB_PLANE;
static_assert(MT_LDS + 65536 <= LDS_BYTES - 64, "stage C LDS map (the grid barrier's words sit in the last 64 bytes)");
__device__ __forceinline__ void fourier_stage_c_block(LAS unsigned char* lds, rsrc_t R, int l, int bx, int G, int tid, int lane, int wave) {
    const int k2t = wave, n = lane & 15, kq = lane >> 4;
    const int upb = (16 * 64 + G - 1) / G, u_lo = bx * upb, u_hi = (u_lo + upb < 16 * 64) ? u_lo + upb : 16 * 64;
    if (u_lo >= u_hi) return;
    bf16x8 wr[4], wi[4], nwi[4];
    { const unsigned wo = (unsigned)(n * 128 + 8 * kq) * 2u; const unsigned tb = OFF_T128 + (unsigned)(16 * k2t * 128) * 2u;
#pragma unroll
      for (int ks = 0; ks < 4; ++ks) { wr[ks] = bld<bf16x8>(R, wo, tb + 64 * ks); wi[ks] = bld<bf16x8>(R, wo, tb + 32768 + 64 * ks); nwi[ks] = bld<bf16x8>(R, wo, tb + 65536 + 64 * ks); } }
    const int trbase = (8 * kq + ((lane & 15) >> 2)) * SLAB_ROWB + 8 * (lane & 3);
    const unsigned fo = (unsigned)tid * 16u;
    const int frow = tid >> 4, fch = tid & 15;
    int mlo = MT_LDS + n * 8 + kq * 1024;
    asm volatile("" : "+v"(mlo));
    const unsigned yo = (unsigned)(64 * n * DM + 4 * kq) * 2u;
    int g_lds = -1;
    u32x4 v[8];
    { const unsigned sb = (unsigned)u_lo * (128 * 128 * 2);
#pragma unroll
      for (int i = 0; i < 8; ++i) v[i] = bld<u32x4>(R, fo, ((i < 4) ? OFF_A2R : OFF_A2I) + sb + (unsigned)(i & 3) * 8192u); }
#pragma unroll 1
    for (int u = u_lo; u < u_hi; ++u) {
        const int k1 = u & 63, bg = u >> 6, b = bg >> 2, g = bg & 3;
        if (g != g_lds) {
            const unsigned mb = OFF_MT + (unsigned)((l * 4 + g) * 128 * 256) * 2u;
#pragma unroll
            for (int i = 0; i < 8; ++i) { const u32x4 mv = bld<u32x4>(R, fo, mb + (unsigned)i * 8192u); *(LAS u32x4*)(lds + MT_LDS + i * 8192 + tid * 16) = mv; }
            g_lds = g;
        }
#pragma unroll
        for (int i = 0; i < 8; ++i) *(LAS u32x4*)(lds + (i < 4 ? 0 : SLAB_PLANE) + (frow + 32 * (i & 3)) * SLAB_ROWB + fch * 16) = v[i];
        __syncthreads();
        if (u + 1 < u_hi) { const unsigned sb = (unsigned)(u + 1) * (128 * 128 * 2);
#pragma unroll
            for (int i = 0; i < 8; ++i) v[i] = bld<u32x4>(R, fo, ((i < 4) ? OFF_A2R : OFF_A2I) + sb + (unsigned)(i & 3) * 8192u); }
        f32x4 zr[8], zi[8];
#pragma unroll
        for (int ct = 0; ct < 8; ++ct) { zr[ct] = (f32x4){0.f, 0.f, 0.f, 0.f}; zi[ct] = (f32x4){0.f, 0.f, 0.f, 0.f}; }
#pragma unroll
        for (int ks = 0; ks < 4; ++ks) {
#pragma unroll
            for (int ct = 0; ct < 8; ++ct) {
                const LAS unsigned char* p = lds + trbase + (32 * ks) * SLAB_ROWB + 32 * ct;
                const v4i16_t r0 = __builtin_amdgcn_ds_read_tr16_b64_v4i16((LAS v4i16_t*)p), r1 = __builtin_amdgcn_ds_read_tr16_b64_v4i16((LAS v4i16_t*)(p + 4 * SLAB_ROWB));
                const v4i16_t i0 = __builtin_amdgcn_ds_read_tr16_b64_v4i16((LAS v4i16_t*)(p + SLAB_PLANE)), i1 = __builtin_amdgcn_ds_read_tr16_b64_v4i16((LAS v4i16_t*)(p + SLAB_PLANE + 4 * SLAB_ROWB));
                const bf16x8 ar = (bf16x8){r0[0], r0[1], r0[2], r0[3], r1[0], r1[1], r1[2], r1[3]}, ai = (bf16x8){i0[0], i0[1], i0[2], i0[3], i1[0], i1[1], i1[2], i1[3]};
                zr[ct] = MFMA16(ar, wr[ks], zr[ct]); zr[ct] = MFMA16(ai, nwi[ks], zr[ct]);
                zi[ct] = MFMA16(ar, wi[ks], zi[ct]); zi[ct] = MFMA16(ai, wr[ks], zi[ct]); }
        }
        f32x4 yv[8];
#pragma unroll
        for (int et = 0; et < 8; ++et) yv[et] = (f32x4){0.f, 0.f, 0.f, 0.f};
        SCHED_FENCE();
#pragma unroll
        for (int kx = 0; kx < 8; ++kx) {
            const int t0 = 2 * (kx & 3), t1 = t0 + 1, cb = (kx >> 2) * 128;
            const f32x4 z0 = (kx < 4) ? zr[t0] : zi[t0], z1 = (kx < 4) ? zr[t1] : zi[t1];
            const u32x4 bw = pg8::pack8(z0, z1); const bf16x8 bfr = __builtin_bit_cast(bf16x8, bw);
#pragma unroll
            for (int et = 0; et < 8; ++et) {
                const u32x2 lo = *(const LAS u32x2*)(lds + mlo + ((cb >> 2) + 4 * t0) * 1024 + et * 128), hi = *(const LAS u32x2*)(lds + mlo + ((cb >> 2) + 4 * t0 + 4) * 1024 + et * 128);
                const u32x4 aw = (u32x4){lo.x, lo.y, hi.x, hi.y}; yv[et] = MFMA16(__builtin_bit_cast(bf16x8, aw), bfr, yv[et]); }
            SCHED_FENCE();
        }
        float s = 0.f;
#pragma unroll
        for (int et = 0; et < 8; ++et) s += pg8::sq4(yv[et]);
        s = pg8::sum_fq(s);
        const float rn = __builtin_amdgcn_rsqf(s * (1.f / HD) + EPS);
        const unsigned yb = OFF_Y + (unsigned)((b * SEQ + k1 + 64 * 16 * k2t) * DM + 1024 + g * HD) * 2u;
#pragma unroll
        for (int et = 0; et < 8; ++et) { u32x2 w; w.x = pg8::cvt_pk_bf16(yv[et][0] * rn, yv[et][1] * rn); w.y = pg8::cvt_pk_bf16(yv[et][2] * rn, yv[et][3] * rn); bst<u32x2>(R, yo, yb + 32 * et, w); }
        __syncthreads();
    }
}

template <bool NA, int QPITCH, int KPITCH, int V_A, int ASTRIDE>
__device__ __forceinline__ void attn16(rsrc_t R, unsigned q_off, unsigned gqk_off, unsigned k_off, unsigned ssk_off, unsigned vt_off, unsigned y_off, unsigned rpb_off, int qcol0, int kc0, int lane) {
    const int n = lane & 15, kq = lane >> 4;
    const int qcol = qcol0 + n; int cs = qcol - 8; cs = cs < 0 ? 0 : (cs > 48 ? 48 : cs);
    bf16x8 kf[3][8]; f32x4 skv[3][2];
    const unsigned ko = NA ? (unsigned)((n >> 3) * 2048 + kq * 128 + (n & 7) * 16) : (unsigned)(n * KPITCH + 8 * kq) * 2u, so = (unsigned)kq * 16u;
#define ATT_LOADK(a_, b_) do { _Pragma("unroll") for (int t = 0; t < 2; ++t) { \
        _Pragma("unroll") for (int ks = 0; ks < 4; ++ks) kf[b_][t * 4 + ks] = bld<bf16x8>(R, ko, k_off + (NA ? (unsigned)((a_) * 131072 + t * 4096 + ks * 512) : (unsigned)(((a_) * ASTRIDE + 16 * t) * KPITCH + 32 * ks) * 2u)); \
        skv[b_][t] = bld<f32x4>(R, so, ssk_off + (unsigned)((a_) * ASTRIDE + 16 * t) * 4u); } } while (0)
    ATT_LOADK(0, 0); ATT_LOADK(1, 1);
    bf16x8 qf[4];
    { float qv[4][8]; float ss = 0.f; const unsigned qo = (unsigned)(n * QPITCH + 8 * kq) * 2u;
#pragma unroll
      for (int ks = 0; ks < 4; ++ks) { const u32x4 raw = bld<u32x4>(R, qo, q_off + 64 * ks);
#pragma unroll
          for (int j = 0; j < 4; ++j) { const unsigned w = raw[j]; qv[ks][2 * j] = __builtin_bit_cast(float, w << 16); qv[ks][2 * j + 1] = __builtin_bit_cast(float, w & 0xffff0000u); ss += qv[ks][2 * j] * qv[ks][2 * j] + qv[ks][2 * j + 1] * qv[ks][2 * j + 1]; } }
      ss = pg8::sum_fq(ss);
      const float rq = __builtin_amdgcn_rsqf(ss * (1.f / HD) + EPS);
#pragma unroll
      for (int ks = 0; ks < 4; ++ks) { const f32x4 g0 = bld<f32x4>(R, (unsigned)kq * 32u, gqk_off + 128 * ks), g1 = bld<f32x4>(R, (unsigned)kq * 32u, gqk_off + 128 * ks + 16);
          u32x4 w; w.x = pg8::cvt_pk_bf16(qv[ks][0] * rq * g0[0], qv[ks][1] * rq * g0[1]); w.y = pg8::cvt_pk_bf16(qv[ks][2] * rq * g0[2], qv[ks][3] * rq * g0[3]);
          w.z = pg8::cvt_pk_bf16(qv[ks][4] * rq * g1[0], qv[ks][5] * rq * g1[1]); w.w = pg8::cvt_pk_bf16(qv[ks][6] * rq * g1[2], qv[ks][7] * rq * g1[3]);
          qf[ks] = __builtin_bit_cast(bf16x8, w); } }
    f32x4 S[8][2];
#pragma unroll
    for (int a = 0; a < 8; ++a) {
        if (a < 6) ATT_LOADK(a + 2, (a + 2) % 3);
        SCHED_FENCE();
#pragma unroll
        for (int t = 0; t < 2; ++t) {
            f32x4 acc = (f32x4){0.f, 0.f, 0.f, 0.f};
#pragma unroll
            for (int ks = 0; ks < 4; ++ks) acc = MFMA16(kf[a % 3][t * 4 + ks], qf[ks], acc);
#pragma unroll
            for (int j = 0; j < 4; ++j) S[a][t][j] = acc[j] * __builtin_amdgcn_rsqf(skv[a % 3][t][j] * (1.f / HD) + EPS);
        }
    }
#undef ATT_LOADK
    u32x2 vlo[2][8], vhi[2][8];
    const unsigned vo = (unsigned)(n * 8 + kq * 1024);
#define ATT_LOADV(a_, b_) do { _Pragma("unroll") for (int dt = 0; dt < 8; ++dt) { vlo[b_][dt] = bld<u32x2>(R, vo, vt_off + (unsigned)(dt * 128 + (a_) * V_A)); vhi[b_][dt] = bld<u32x2>(R, vo, vt_off + (unsigned)(dt * 128 + (a_) * V_A + 4096)); } } while (0)
    ATT_LOADV(0, 0);
    if (NA) {
        unsigned bo[8]; float bb[8][8];
#pragma unroll
        for (int q = 0; q < 8; ++q) { int ci = kc0 + 16 * (q >> 2) + 4 * kq + (q & 3) - qcol + 15; ci = ci < 0 ? 0 : (ci > 30 ? 30 : ci); bo[q] = (unsigned)ci * 4u; }
#pragma unroll
        for (int a = 0; a < 8; ++a)
#pragma unroll
            for (int q = 0; q < 8; ++q) bb[a][q] = bld<float>(R, bo[q], rpb_off + (unsigned)a * 124u);
        SCHED_FENCE();
#pragma unroll
        for (int a = 0; a < 8; ++a)
#pragma unroll
            for (int q = 0; q < 8; ++q) { const int kcol = kc0 + 16 * (q >> 2) + 4 * kq + (q & 3); const bool valid = (kcol >= cs) && (kcol < cs + 16); S[a][q >> 2][q & 3] = valid ? S[a][q >> 2][q & 3] + bb[a][q] : -1e30f; }
    }
    SCHED_FENCE();
    float mx = -3e38f;
#pragma unroll
    for (int a = 0; a < 8; ++a)
#pragma unroll
        for (int t = 0; t < 2; ++t)
#pragma unroll
            for (int j = 0; j < 4; ++j) mx = fmaxf(mx, S[a][t][j]);
    mx = pg8::max_fq(mx);
    float sum = 0.f;
#pragma unroll
    for (int a = 0; a < 8; ++a) {
#pragma unroll
        for (int t = 0; t < 2; ++t)
#pragma unroll
            for (int j = 0; j < 4; ++j) { const float p = __expf(S[a][t][j] - mx); S[a][t][j] = p; sum += p; }
        SCHED_FENCE();
    }
    sum = pg8::sum_fq(sum);
    f32x4 o[8];
#pragma unroll
    for (int dt = 0; dt < 8; ++dt) o[dt] = (f32x4){0.f, 0.f, 0.f, 0.f};
#pragma unroll
    for (int a = 0; a < 8; ++a) {
        if (a < 7) ATT_LOADV(a + 1, (a + 1) & 1);
        SCHED_FENCE();
        const u32x4 pw = pg8::pack8(S[a][0], S[a][1]); const bf16x8 pf = __builtin_bit_cast(bf16x8, pw);
#pragma unroll
        for (int dt = 0; dt < 8; ++dt) { const u32x4 vw = (u32x4){vlo[a & 1][dt].x, vlo[a & 1][dt].y, vhi[a & 1][dt].x, vhi[a & 1][dt].y}; o[dt] = MFMA16(__builtin_bit_cast(bf16x8, vw), pf, o[dt]); }
        SCHED_FENCE();
    }
#undef ATT_LOADV
    const float inv = __builtin_amdgcn_rcpf(sum); float ss = 0.f;
#pragma unroll
    for (int dt = 0; dt < 8; ++dt) { o[dt] = o[dt] * inv; ss += pg8::sq4(o[dt]); }
    ss = pg8::sum_fq(ss);
    const float rn = __builtin_amdgcn_rsqf(ss * (1.f / HD) + EPS);
    const unsigned yo = (unsigned)(n * DM + 4 * kq) * 2u;
#pragma unroll
    for (int dt = 0; dt < 8; ++dt) { u32x2 w; w.x = pg8::cvt_pk_bf16(o[dt][0] * rn, o[dt][1] * rn); w.y = pg8::cvt_pk_bf16(o[dt][2] * rn, o[dt][3] * rn); bst<u32x2>(R, yo, y_off + 32 * dt, w); }
}

constexpr int MK_ROWB = 272, MV_KGB = 1152, MEM_LDS_V = 256 * MK_ROWB, MEM_LDS_S = MEM_LDS_V + 64 * MV_KGB;
static_assert(MEM_LDS_S + 1024 <= LDS_BYTES - 64, "memory attention LDS map");
__device__ __forceinline__ void mem_attn_block(LAS unsigned char* lds, rsrc_t R, int l, int bx, int G, int tid, int lane, int wave) {
    const int n = lane & 15, kq = lane >> 4;
#pragma unroll 1
    for (int u = bx; u < 256; u += G) {
        const int bh = u >> 4, qr = u & 15, b = bh >> 2, h = bh & 3;
        { const unsigned kvo = (unsigned)((tid >> 4) * 1024 + (tid & 15) * 16), ksb = OFF_KM + (unsigned)(l * 1024 * 512 + b * NMEM * 512 + h * HD) * 2u;
          const unsigned vsb = OFF_VMT + (unsigned)(l * 1048576 + (b * 4 + h) * 65536);
          u32x4 kv[8], vv[8];
#pragma unroll
          for (int i = 0; i < 8; ++i) { kv[i] = bld<u32x4>(R, kvo, ksb + (unsigned)i * 32768u); vv[i] = bld<u32x4>(R, (unsigned)tid * 16u, vsb + (unsigned)i * 8192u); }
          float ssv = 1.f; if (tid < 256) ssv = bld<float>(R, (unsigned)tid * 4u, OFF_SS + (unsigned)(SS_MK + (l * 4 + h) * 1024 + b * NMEM) * 4u);
#pragma unroll
          for (int i = 0; i < 8; ++i) { *(LAS u32x4*)(lds + ((tid >> 4) + 32 * i) * MK_ROWB + (tid & 15) * 16) = kv[i]; *(LAS u32x4*)(lds + MEM_LDS_V + ((tid >> 6) + 8 * i) * MV_KGB + (tid & 63) * 16) = vv[i]; }
          if (tid < 256) *(LAS float*)(lds + MEM_LDS_S + tid * 4) = __builtin_amdgcn_rsqf(ssv * (1.f / HD) + EPS); }
        __syncthreads();
        int kb = n * MK_ROWB + kq * 16; asm volatile("" : "+v"(kb));
        int vb0 = MEM_LDS_V + kq * MV_KGB + n * 8; asm volatile("" : "+v"(vb0));
        int vb1 = MEM_LDS_V + (kq + 32) * MV_KGB + n * 8; asm volatile("" : "+v"(vb1));
        int sb = MEM_LDS_S + kq * 16; asm volatile("" : "+v"(sb));
        const unsigned qo = (unsigned)(n * PROJ_W + 8 * kq) * 2u, yo = (unsigned)(n * DM + 4 * kq) * 2u;
        const int tok0 = b * SEQ + qr * 512 + wave * 64;
        const unsigned gqk_off = OFF_GQK + (unsigned)((l * 2 + 1) * HD) * 4u;
        u32x4 raw[4];
#pragma unroll
        for (int ks = 0; ks < 4; ++ks) raw[ks] = bld<u32x4>(R, qo, OFF_PROJ + (unsigned)(tok0 * PROJ_W + 2560 + h * HD) * 2u + 64 * ks);
#pragma unroll 1
        for (int i = 0; i < 4; ++i) {
            bf16x8 qf[4];
            { float qv[4][8]; float ss = 0.f;
#pragma unroll
              for (int ks = 0; ks < 4; ++ks)
#pragma unroll
                  for (int j = 0; j < 4; ++j) { const unsigned w = raw[ks][j]; qv[ks][2 * j] = __builtin_bit_cast(float, w << 16); qv[ks][2 * j + 1] = __builtin_bit_cast(float, w & 0xffff0000u); ss += qv[ks][2 * j] * qv[ks][2 * j] + qv[ks][2 * j + 1] * qv[ks][2 * j + 1]; }
              ss = pg8::sum_fq(ss);
              const float rq = __builtin_amdgcn_rsqf(ss * (1.f / HD) + EPS);
#pragma unroll
              for (int ks = 0; ks < 4; ++ks) { const f32x4 g0 = bld<f32x4>(R, (unsigned)kq * 32u, gqk_off + 128 * ks), g1 = bld<f32x4>(R, (unsigned)kq * 32u, gqk_off + 128 * ks + 16);
                  u32x4 w; w.x = pg8::cvt_pk_bf16(qv[ks][0] * rq * g0[0], qv[ks][1] * rq * g0[1]); w.y = pg8::cvt_pk_bf16(qv[ks][2] * rq * g0[2], qv[ks][3] * rq * g0[3]);
                  w.z = pg8::cvt_pk_bf16(qv[ks][4] * rq * g1[0], qv[ks][5] * rq * g1[1]); w.w = pg8::cvt_pk_bf16(qv[ks][6] * rq * g1[2], qv[ks][7] * rq * g1[3]);
                  qf[ks] = __builtin_bit_cast(bf16x8, w); } }
            { const int tn = tok0 + 16 * (i < 3 ? i + 1 : i);
#pragma unroll
              for (int ks = 0; ks < 4; ++ks) raw[ks] = bld<u32x4>(R, qo, OFF_PROJ + (unsigned)(tn * PROJ_W + 2560 + h * HD) * 2u + 64 * ks); }
            f32x4 S[8][2];
#pragma unroll
            for (int a = 0; a < 8; ++a) {
#pragma unroll
                for (int t = 0; t < 2; ++t) {
                    f32x4 acc = (f32x4){0.f, 0.f, 0.f, 0.f};
#pragma unroll
                    for (int ks = 0; ks < 4; ++ks) { const bf16x8 kf = *(const LAS bf16x8*)(lds + kb + (32 * a + 16 * t) * MK_ROWB + 64 * ks); acc = MFMA16(kf, qf[ks], acc); }
                    const f32x4 rk = *(const LAS f32x4*)(lds + sb + (32 * a + 16 * t) * 4);
                    S[a][t] = acc * rk;
                }
                SCHED_FENCE();
            }
            float mx = -3e38f;
#pragma unroll
            for (int a = 0; a < 8; ++a)
#pragma unroll
                for (int t = 0; t < 2; ++t)
#pragma unroll
                    for (int j = 0; j < 4; ++j) mx = fmaxf(mx, S[a][t][j]);
            mx = pg8::max_fq(mx);
            float sum = 0.f;
#pragma unroll
            for (int a = 0; a < 8; ++a) {
#pragma unroll
                for (int t = 0; t < 2; ++t)
#pragma unroll
                    for (int j = 0; j < 4; ++j) { const float p = __expf(S[a][t][j] - mx); S[a][t][j] = p; sum += p; }
                SCHED_FENCE();
            }
            sum = pg8::sum_fq(sum);
            f32x4 o[8];
#pragma unroll
            for (int dt = 0; dt < 8; ++dt) o[dt] = (f32x4){0.f, 0.f, 0.f, 0.f};
#pragma unroll
            for (int a = 0; a < 8; ++a) {
                const u32x4 pw = pg8::pack8(S[a][0], S[a][1]); const bf16x8 pf = __builtin_bit_cast(bf16x8, pw);
#pragma unroll
                for (int dt = 0; dt < 8; ++dt) {
                    const int vb = (a < 4) ? vb0 : vb1; const int off = (8 * (a & 3)) * MV_KGB + dt * 128;
                    const u32x2 lo = *(const LAS u32x2*)(lds + vb + off), hi = *(const LAS u32x2*)(lds + vb + off + 4 * MV_KGB);
                    const u32x4 vw = (u32x4){lo.x, lo.y, hi.x, hi.y}; o[dt] = MFMA16(__builtin_bit_cast(bf16x8, vw), pf, o[dt]); }
                SCHED_FENCE();
            }
            const float inv = __builtin_amdgcn_rcpf(sum); float ss = 0.f;
#pragma unroll
            for (int dt = 0; dt < 8; ++dt) { o[dt] = o[dt] * inv; ss += pg8::sq4(o[dt]); }
            ss = pg8::sum_fq(ss);
            const float rn = __builtin_amdgcn_rsqf(ss * (1.f / HD) + EPS);
            const unsigned y_off = OFF_Y + (unsigned)((tok0 + 16 * i) * DM + 1536 + h * HD) * 2u;
#pragma unroll
            for (int dt = 0; dt < 8; ++dt) { u32x2 w; w.x = pg8::cvt_pk_bf16(o[dt][0] * rn, o[dt][1] * rn); w.y = pg8::cvt_pk_bf16(o[dt][2] * rn, o[dt][3] * rn); bst<u32x2>(R, yo, y_off + 32 * dt, w); }
        }
        __syncthreads();
    }
}

constexpr int NA_BUF = 32768, NA_SSK = 2 * NA_BUF, NA_RPB = NA_SSK + 4096, NA_LDS_END = NA_RPB + 8 * 15 * 31 * 4;
static_assert(NA_LDS_END <= LDS_BYTES - 64, "neighbourhood attention LDS map");
__device__ __forceinline__ void na_attn_block(LAS unsigned char* lds, rsrc_t R, int l, int bx, int G, int tid, int lane, int wave) {
    const int n = lane & 15, kq = lane >> 4, qg = wave & 3, hsel = wave >> 2;
    const int kc0 = (qg == 0) ? 0 : (qg == 1 ? 8 : (qg == 2 ? 24 : 32));
    const int qcol = 16 * qg + n; int cs = qcol - 8; cs = cs < 0 ? 0 : (cs > 48 ? 48 : cs);
    for (int i = tid; i < 8 * 15 * 31; i += NWAVES * 64) *(LAS float*)(lds + NA_RPB + i * 4) = bld<float>(R, (unsigned)i * 4u, OFF_RPB + (unsigned)(l * 8 * 15 * 31) * 4u);
    const unsigned co = (unsigned)tid * 16u;
    int kfb = hsel * 16384 + ((kc0 >> 3) + (n >> 3)) * 2048 + kq * 128 + (n & 7) * 16;
    int vfb = hsel * 16384 + ((kc0 >> 2) + kq) * 1024 + n * 8;
    int skb = NA_SSK + (hsel * 64 + kc0 + 4 * kq) * 4;
    asm volatile("" : "+v"(kfb), "+v"(vfb), "+v"(skb));
    const unsigned qo = (unsigned)(n * PROJ_W + 8 * kq) * 2u, yo = (unsigned)(n * DM + 4 * kq) * 2u;
    const unsigned gqk_off = OFF_GQK + (unsigned)((l * 2 + 0) * HD) * 4u;
#pragma unroll 1
    for (int u = bx; u < BATCH * 128 * 4; u += G) {
        const int hp = u & 3, r = (u >> 2) & 127, b = u >> 9, h = 2 * hp + hsel;
        int start = r - 4; start = start < 0 ? 0 : (start > 120 ? 120 : start);
        const unsigned rowb = (unsigned)(((b * 128 + start) * 8 + 2 * hp) * 16384);
        u32x4 st[3][4];
#define NA_ISSUE(seq_, slot_) do { _Pragma("unroll") for (int j = 0; j < 4; ++j) st[slot_][j] = bld<u32x4>(R, co, ((seq_) < 8 ? (unsigned)WS_KB + rowb + (unsigned)((seq_) * 131072) : OFF_VT + rowb + (unsigned)(((seq_) - 8) * 131072)) + (unsigned)j * 8192u); } while (0)
#define NA_WRITE(slot_, buf_) do { _Pragma("unroll") for (int j = 0; j < 4; ++j) *(LAS u32x4*)(lds + (buf_) * NA_BUF + j * 8192 + tid * 16) = st[slot_][j]; } while (0)
        NA_ISSUE(0, 0); NA_ISSUE(1, 1); NA_ISSUE(2, 2);
        { const int hs = wave & 1, a0 = wave >> 1;
          const unsigned sso = OFF_SS + (unsigned)(SS_H + (size_t)(l * 20 + 2 * hp + hs) * NTOK + b * SEQ + (start + a0) * 64) * 4u;
          const float s0 = bld<float>(R, (unsigned)(lane * 4), sso), s1 = bld<float>(R, (unsigned)(lane * 4), sso + 4u * 64u * 4u);
          *(LAS float*)(lds + NA_SSK + tid * 4) = __builtin_amdgcn_rsqf(s0 * (1.f / HD) + EPS); *(LAS float*)(lds + NA_SSK + (tid + 512) * 4) = __builtin_amdgcn_rsqf(s1 * (1.f / HD) + EPS); }
        bf16x8 qf[4];
        { float qv[4][8]; float ss = 0.f; const unsigned q_off = OFF_PROJ + (unsigned)((b * SEQ + r * 64 + 16 * qg) * PROJ_W + h * HD) * 2u;
#pragma unroll
          for (int ks = 0; ks < 4; ++ks) { const u32x4 raw = bld<u32x4>(R, qo, q_off + 64 * ks);
#pragma unroll
              for (int j = 0; j < 4; ++j) { const unsigned w = raw[j]; qv[ks][2 * j] = __builtin_bit_cast(float, w << 16); qv[ks][2 * j + 1] = __builtin_bit_cast(float, w & 0xffff0000u); ss += qv[ks][2 * j] * qv[ks][2 * j] + qv[ks][2 * j + 1] * qv[ks][2 * j + 1]; } }
          ss = pg8::sum_fq(ss);
          const float rq = __builtin_amdgcn_rsqf(ss * (1.f / HD) + EPS);
#pragma unroll
          for (int ks = 0; ks < 4; ++ks) { const f32x4 g0 = bld<f32x4>(R, (unsigned)kq * 32u, gqk_off + 128 * ks), g1 = bld<f32x4>(R, (unsigned)kq * 32u, gqk_off + 128 * ks + 16);
              u32x4 w; w.x = pg8::cvt_pk_bf16(qv[ks][0] * rq * g0[0], qv[ks][1] * rq * g0[1]); w.y = pg8::cvt_pk_bf16(qv[ks][2] * rq * g0[2], qv[ks][3] * rq * g0[3]);
              w.z = pg8::cvt_pk_bf16(qv[ks][4] * rq * g1[0], qv[ks][5] * rq * g1[1]); w.w = pg8::cvt_pk_bf16(qv[ks][6] * rq * g1[2], qv[ks][7] * rq * g1[3]);
              qf[ks] = __builtin_bit_cast(bf16x8, w); } }
        NA_WRITE(0, 0);
        __syncthreads();
        f32x4 S[8][2];
#pragma unroll
        for (int a = 0; a < 8; ++a) {
            NA_ISSUE(a + 3, a % 3);
            SCHED_FENCE();
            const int buf = (a & 1) * NA_BUF;
#pragma unroll
            for (int t = 0; t < 2; ++t) {
                f32x4 acc = (f32x4){0.f, 0.f, 0.f, 0.f};
#pragma unroll
                for (int ks = 0; ks < 4; ++ks) { const bf16x8 kf = *(const LAS bf16x8*)(lds + kfb + buf + t * 4096 + ks * 512); acc = MFMA16(kf, qf[ks], acc); }
                const f32x4 rk = *(const LAS f32x4*)(lds + skb + a * 512 + t * 64);
                S[a][t] = acc * rk;
            }
            SCHED_FENCE();
            NA_WRITE((a + 1) % 3, (a + 1) & 1);
            __syncthreads();
        }
        { const int rowidx0 = start - r + 7;
#pragma unroll
          for (int a = 0; a < 8; ++a)
#pragma unroll
              for (int q = 0; q < 8; ++q) { const int kcol = kc0 + 16 * (q >> 2) + 4 * kq + (q & 3); const bool valid = (kcol >= cs) && (kcol < cs + 16);
                  int ci = kcol - qcol + 15; ci = ci < 0 ? 0 : (ci > 30 ? 30 : ci);
                  const float bias = *(const LAS float*)(lds + NA_RPB + ((h * 15 + rowidx0 + a) * 31 + ci) * 4);
                  S[a][q >> 2][q & 3] = valid ? S[a][q >> 2][q & 3] + bias : -1e30f; } }
        float mx = -3e38f;
#pragma unroll
        for (int a = 0; a < 8; ++a)
#pragma unroll
            for (int t = 0; t < 2; ++t)
#pragma unroll
                for (int j = 0; j < 4; ++j) mx = fmaxf(mx, S[a][t][j]);
        mx = pg8::max_fq(mx);
        float sum = 0.f;
#pragma unroll
        for (int a = 0; a < 8; ++a) {
#pragma unroll
            for (int t = 0; t < 2; ++t)
#pragma unroll
                for (int j = 0; j < 4; ++j) { const float p = __expf(S[a][t][j] - mx); S[a][t][j] = p; sum += p; }
            SCHED_FENCE();
        }
        sum = pg8::sum_fq(sum);
        f32x4 o[8];
#pragma unroll
        for (int dt = 0; dt < 8; ++dt) o[dt] = (f32x4){0.f, 0.f, 0.f, 0.f};
#pragma unroll
        for (int a = 0; a < 8; ++a) {
            if (a + 3 < 8) NA_ISSUE(8 + a + 3, (8 + a) % 3);
            SCHED_FENCE();
            const int buf = (a & 1) * NA_BUF;
            const u32x4 pw = pg8::pack8(S[a][0], S[a][1]); const bf16x8 pf = __builtin_bit_cast(bf16x8, pw);
#pragma unroll
            for (int dt = 0; dt < 8; ++dt) { const u32x2 lo = *(const LAS u32x2*)(lds + vfb + buf + dt * 128), hi = *(const LAS u32x2*)(lds + vfb + buf + dt * 128 + 4096);
                const u32x4 vw = (u32x4){lo.x, lo.y, hi.x, hi.y}; o[dt] = MFMA16(__builtin_bit_cast(bf16x8, vw), pf, o[dt]); }
            SCHED_FENCE();
            if (a < 7) NA_WRITE((8 + a + 1) % 3, (a + 1) & 1);
            __syncthreads();
        }
#undef NA_ISSUE
#undef NA_WRITE
        const float inv = __builtin_amdgcn_rcpf(sum); float ss = 0.f;
#pragma unroll
        for (int dt = 0; dt < 8; ++dt) { o[dt] = o[dt] * inv; ss += pg8::sq4(o[dt]); }
        ss = pg8::sum_fq(ss);
        const float rn = __builtin_amdgcn_rsqf(ss * (1.f / HD) + EPS);
        const unsigned y_off = OFF_Y + (unsigned)((b * SEQ + r * 64 + 16 * qg) * DM + h * HD) * 2u;
#pragma unroll
        for (int dt = 0; dt < 8; ++dt) { u32x2 w; w.x = pg8::cvt_pk_bf16(o[dt][0] * rn, o[dt][1] * rn); w.y = pg8::cvt_pk_bf16(o[dt][2] * rn, o[dt][3] * rn); bst<u32x2>(R, yo, y_off + 32 * dt, w); }
    }
}

#define RLX_AGENT __ATOMIC_RELAXED, __HIP_MEMORY_SCOPE_AGENT
#define XB_TMO      128
#define XB_XCNT(j)  (256  + 64 * (j))
#define XB_XSUB(j)  (1280 + 64 * (j))
#define XB_XGEN(j)  (2304 + 64 * (j))
#define XB_TOP      3328
#define XB_TOPGEN   3392
#define XCD_BAR_WORDS 3456
#define XB_SPIN_CAP (1u << 18)

__device__ __forceinline__ unsigned xb_ld(unsigned* p)              { return __hip_atomic_load(p, __ATOMIC_RELAXED, __HIP_MEMORY_SCOPE_AGENT); }
__device__ __forceinline__ unsigned xb_add(unsigned* p, unsigned v) { return __hip_atomic_fetch_add(p, v, __ATOMIC_RELAXED, __HIP_MEMORY_SCOPE_AGENT); }
__device__ __forceinline__ unsigned xb_xcc_id() { return (unsigned)__builtin_amdgcn_s_getreg((3 << 11) | 20) & 0xFu; }
#define XB_SPIN(cond, bar) do { unsigned _sp = 0; while (cond) { __builtin_amdgcn_s_sleep(1); \
    if ((++_sp & 255u) == 0u) { if (xb_ld(&(bar)[XB_TMO])) break; if (_sp > XB_SPIN_CAP) { atomicAdd(&(bar)[XB_TMO], 1u); break; } } } } while (0)

struct XcdBarrier {
    unsigned* bar; unsigned x;
    volatile LAS unsigned* st;
};

__device__ __forceinline__ XcdBarrier xcd_barrier_post(unsigned* bar, volatile LAS unsigned* st) {
    XcdBarrier b; b.bar = bar; b.x = xb_xcc_id(); b.st = st;
    if (threadIdx.x == 0) (void)xb_add(&bar[XB_XCNT(b.x)], 1u);
    return b;
}
__device__ __forceinline__ void xcd_barrier_complete(unsigned* bar, unsigned x, unsigned& nloc, unsigned& nx) {
    const unsigned G = gridDim.x * gridDim.y * gridDim.z;
    unsigned sum, cnt, mine, sp = 0u;
    for (;;) {
        sum = 0u; cnt = 0u; mine = 0u;
#pragma unroll
        for (unsigned j = 0; j < 16; ++j) { const unsigned c = xb_ld(&bar[XB_XCNT(j)]); sum += c; cnt += (c > 0u) ? 1u : 0u; mine = (j == x) ? c : mine; }
        if (sum == G) break;
        __builtin_amdgcn_s_sleep(1);
        if ((++sp & 255u) == 0u) { if (xb_ld(&bar[XB_TMO])) break; if (sp > XB_SPIN_CAP) { atomicAdd(&bar[XB_TMO], 1u); break; } }
    }
    nloc = mine > 0u ? mine : 1u; nx = cnt > 0u ? cnt : 1u;
}

__device__ __forceinline__ void xcd_barrier(const XcdBarrier& b) {
    asm volatile("s_waitcnt vmcnt(0)" ::: "memory");
    __syncthreads();
    if (threadIdx.x == 0) {
        unsigned* bar = b.bar;
        __builtin_amdgcn_s_waitcnt(0);
        unsigned nloc = b.st[0], nx = b.st[1];
        if (nloc == 0u) { xcd_barrier_complete(bar, b.x, nloc, nx); b.st[0] = nloc; b.st[1] = nx; }
        const unsigned old = xb_add(&bar[XB_XSUB(b.x)], 1u);
        const unsigned gen = old / nloc;
        if (old + 1u == (gen + 1u) * nloc) {
            __builtin_amdgcn_fence(__ATOMIC_RELEASE, "agent");
            asm volatile("s_waitcnt vmcnt(0)" ::: "memory");
            const unsigned og = xb_add(&bar[XB_TOP], 1u);
            const unsigned tg = og / nx;
            if (og + 1u == (tg + 1u) * nx) xb_add(&bar[XB_TOPGEN], 1u);
            else XB_SPIN(xb_ld(&bar[XB_TOPGEN]) == tg, bar);
            __builtin_amdgcn_fence(__ATOMIC_ACQUIRE, "agent");
            xb_add(&bar[XB_XGEN(b.x)], 1u);
            asm volatile("s_waitcnt vmcnt(0)" ::: "memory");
        } else {
            XB_SPIN(xb_ld(&bar[XB_XGEN(b.x)]) == gen, bar);
            __builtin_amdgcn_fence(__ATOMIC_ACQUIRE, "agent");
            asm volatile("s_waitcnt vmcnt(0)" ::: "memory");
        }
    }
    __syncthreads();
}

__global__ void __launch_bounds__(NWAVES * 64, 2) mega_fwd(Args args) {
    extern __shared__ __attribute__((aligned(16))) unsigned char lds_raw[];
    LAS unsigned char* lds = (LAS unsigned char*)lds_raw;

    const int wave = __builtin_amdgcn_readfirstlane((int)threadIdx.x >> 6);
    if (threadIdx.x < 16) ((LAS unsigned*)(lds + LDS_BYTES - 64))[threadIdx.x] = 0u;
    __syncthreads();
    const XcdBarrier xbar = xcd_barrier_post((unsigned*)args.ws, (volatile LAS unsigned*)(lds + LDS_BYTES - 64));
    for (int ph = args.ph_lo; ph < args.ph_hi; ++ph) {
        unsigned char* ws = args.ws; asm volatile("" : "+s"(ws));
#define FRESH_TID(name) int name; asm volatile("v_mbcnt_lo_u32_b32 %0, -1, 0\n\tv_mbcnt_hi_u32_b32 %0, -1, %0" : "=v"(name)); name += wave * 64
        const int G = gridDim.x, bx = blockIdx.x, vcu = (G % 8 == 0) ? (bx % 8) * (G / 8) + bx / 8 : bx;
        const int gw = vcu * NWAVES + wave, NGW = G * NWAVES;
        float* ss = (float*)(ws + WS_SS);
        bf16_t* xb = (bf16_t*)(ws + WS_XB); bf16_t* proj = (bf16_t*)(ws + WS_PROJ); bf16_t* VT = (bf16_t*)(ws + WS_VT); bf16_t* yb = (bf16_t*)(ws + WS_Y);
        bf16_t* A2r = (bf16_t*)(ws + WS_A2); bf16_t* A2i = A2r + (size_t)16 * 64 * 128 * 128; bf16_t* hid = (bf16_t*)(ws + WS_H);
        bf16_t* memb = (bf16_t*)(ws + WS_MEMB); bf16_t* Km = (bf16_t*)(ws + WS_KM); bf16_t* VmT = (bf16_t*)(ws + WS_VMT);
        const bf16_t* T64 = (const bf16_t*)(ws + WS_TAB + TAB_T64); const bf16_t* T128 = (const bf16_t*)(ws + WS_TAB + TAB_T128); const bf16_t* MT = (const bf16_t*)(ws + WS_TAB + TAB_MT); const float* GQK = (const float*)(ws + WS_TAB + TAB_GQK);
        if (ph < NPRO) { FRESH_TID(tid); prologue(args, ws, lds, tid, tid & 63, wave, vcu, G); }
        else {
            const int l = (ph - NPRO) / LSEQ_N, k = (int)((LSEQ >> (4 * ((ph - NPRO) % LSEQ_N))) & 15ull);
            float* ssx_in1 = ss + SS_X + (size_t)(2 * l) * NTOK;
            float* ssx_mid = ss + SS_X + (size_t)(2 * l + 1) * NTOK;
            float* ssx_out = ss + SS_X + (size_t)(2 * l + 2) * NTOK;
            float* sshl = ss + SS_H + (size_t)l * 20 * NTOK;
            if (k == 0) {
                const int n1 = (l == 0) ? 3 : 1;
#pragma unroll 1
                for (int gi = 0; gi < n1; ++gi) {
                    pg8::Gemm g; pg8::EpiProj E; pg8::StaticOrder S;
                    if (gi == 0) { g = pg8::Gemm{xb, (const bf16_t*)(ws + WS_WIN) + (size_t)l * DIN * DM, NTOK, PROJ_W, DM};
                        E = pg8::EpiProj{proj, PROJ_W, ssx_in1, 1.f / DM, sshl, NTOK, 4, 8, (bf16_t*)(ws + WS_KB), 4, 8}; S.init(NTOK, PROJ_W, G, bx); }
                    else { const int lm = gi - 1;
                        g = pg8::Gemm{memb, (const bf16_t*)(ws + WS_WMKV) + (size_t)lm * 1024 * DM, BATCH * NMEM, 512, DM};
                        E = pg8::EpiProj{Km + (size_t)lm * 1024 * 512, 512, nullptr, 0.f, ss + SS_MK + (size_t)lm * 4 * 1024 - (size_t)0, 1024, 0, 2, nullptr, 1000, 1000}; S.init(BATCH * NMEM, 512, G, (bx + G - 8 * lm) % G); }
                    pg8::gemm_phase<pg8::EpiProj, pg8::StaticOrder, PG8_ALIGN, PG8_SP2>(lds, g, S, E, wave);
                }
#pragma unroll 1
                for (int gi = 0; gi < n1; ++gi) {
                    pg8::Gemm g; pg8::EpiColScale E; pg8::StaticOrder S;
                    if (gi == 0) { g = pg8::Gemm{(const bf16_t*)(ws + WS_WIN) + (size_t)l * DIN * DM + (size_t)3072 * DM, xb, 1024, NTOK, DM};
                        E = pg8::EpiColScale{VT, 6, 8, ssx_in1, 1.f / DM}; S.init(1024, NTOK, G, bx); }
                    else { const int lm = gi - 1;
                        g = pg8::Gemm{(const bf16_t*)(ws + WS_WMKV) + (size_t)lm * 1024 * DM + (size_t)512 * DM, memb, 512, BATCH * NMEM, DM};
                        E = pg8::EpiColScale{VmT + (size_t)lm * 512 * 1024, 8, 4, nullptr, 0.f}; S.init(512, BATCH * NMEM, G, (bx + G - 16 - 8 * lm) % G); }
                    pg8::gemm_phase<pg8::EpiColScale, pg8::StaticOrder, PG8_ALIGN, PG8_SP2>(lds, g, S, E, wave);
                }
            } else if (k == 1) {
                FRESH_TID(tid); const int lane = tid & 63;
                const rsrc_t R = make_rsrc(ws);
                for (int it = gw; it < 16 * 128; it += NGW) fourier_stage_a(R, it, lane);
                mem_attn_block(lds, R, l, bx, G, tid, lane, wave);
            } else if (k == 2) {
                FRESH_TID(tid); const int lane = tid & 63;
                const rsrc_t R = make_rsrc(ws);
                fourier_stage_c_block(lds, R, l, bx, G, tid, lane, wave);
                na_attn_block(lds, R, l, bx, G, tid, lane, wave);
            } else if (k == 3 || k == 5) {
                pg8::Gemm g; pg8::EpiResid E; pg8::StaticOrder S; S.init(NTOK, DM, G, bx);
                if (k == 3) { g = pg8::Gemm{yb, (const bf16_t*)(ws + WS_WOUT) + (size_t)l * DM * DM, NTOK, DM, DM};
                    E = pg8::EpiResid{xb, nullptr, ssx_mid, DM}; }
                else { g = pg8::Gemm{hid, (const bf16_t*)(ws + WS_WDN) + (size_t)l * DM * DFF, NTOK, DM, DFF};
                    E = pg8::EpiResid{xb, (l == 1) ? args.out : nullptr, ssx_out, DM}; }
                pg8::gemm_phase<pg8::EpiResid, pg8::StaticOrder, PG8_ALIGN, PG8_SP2>(lds, g, S, E, wave);
            } else {
                pg8::Gemm g{xb, (const bf16_t*)(ws + WS_WGU) + (size_t)l * 2 * DFF * DM, NTOK, 2 * DFF, DM}; pg8::StaticOrder S; S.init(NTOK, 2 * DFF, G, bx);
                pg8::EpiSwiGLU E{hid, DFF, ssx_mid, 1.f / DM};
                pg8::gemm_phase<pg8::EpiSwiGLU, pg8::StaticOrder, PG8_ALIGN, PG8_SP2>(lds, g, S, E, wave);
            }
        }
        if (ph + 1 < args.ph_hi) { if (args.ph_lo < 0) cg::this_grid().sync(); else xcd_barrier(xbar); }
    }
}

extern "C" void kernel_launch(void* const* d_in, const int* in_sizes, int n_in, void* d_out, int out_size, void* d_ws, size_t ws_size, hipStream_t stream) {
    static int grid = 0;
    if (grid == 0) {
        if (n_in != 18 || out_size != NTOK * DM || ws_size < WS_END) { fprintf(stderr, "kernel_launch: unexpected shapes (n_in %d, out %d, ws %zu); nothing launched\n", n_in, out_size, ws_size); grid = -1; return; }
        int dev = 0, cus = 0, per_cu = 0;
        (void)hipGetDevice(&dev); (void)hipDeviceGetAttribute(&cus, hipDeviceAttributeMultiprocessorCount, dev);
        if (hipFuncSetAttribute((const void*)mega_fwd, hipFuncAttributeMaxDynamicSharedMemorySize, LDS_BYTES) != hipSuccess) { fprintf(stderr, "kernel_launch: hipFuncSetAttribute failed\n"); grid = -1; return; }
        if (hipOccupancyMaxActiveBlocksPerMultiprocessor(&per_cu, (const void*)mega_fwd, NWAVES * 64, LDS_BYTES) != hipSuccess || per_cu < 1) { fprintf(stderr, "kernel_launch: occupancy query gave %d\n", per_cu); per_cu = 1; }
        (void)hipGetLastError();
        if (cus <= 0) cus = 256;
        grid = cus;
    }
    if (grid < 0) return;
    if (hipMemsetAsync(d_ws, 0, 16384, stream) != hipSuccess) { fprintf(stderr, "kernel_launch: memset of the barrier words failed\n"); return; }
    Args a{};
    for (int i = 0; i < 18; ++i) a.in[i] = (const float*)d_in[i];
    a.out = (float*)d_out; a.ws = (unsigned char*)d_ws;
#if MK_LAUNCHES == 1
    a.ph_lo = 0; a.ph_hi = NPH;
    void* kargs[] = {&a};
    const hipError_t e = hipLaunchCooperativeKernel((const void*)mega_fwd, dim3(grid), dim3(NWAVES * 64), kargs, LDS_BYTES, stream);
    if (e != hipSuccess) fprintf(stderr, "kernel_launch: cooperative launch failed: %s (grid %d)\n", hipGetErrorString(e), grid);
#else
    for (int ph = 0; ph < NPH; ++ph) { a.ph_lo = ph; a.ph_hi = ph + 1; hipLaunchKernelGGL(mega_fwd, dim3(grid), dim3(NWAVES * 64), LDS_BYTES, stream, a); }
#endif
}
```

```cpp
#include <hip/hip_runtime.h>
#include <hip/hip_cooperative_groups.h>
#include <cstdio>
#include <cstdint>
namespace cg = cooperative_groups;
namespace pg8 {
#define PG8_LAS __attribute__((address_space(3)))
typedef unsigned short bf16_t;
typedef short bf16x8 __attribute__((ext_vector_type(8)));
typedef float f32x4 __attribute__((ext_vector_type(4)));
typedef unsigned u32x4 __attribute__((ext_vector_type(4)));
constexpr int BM = 256, BK = 64, HALF = 128, HTB = HALF * BK * 2  , STAGE_BYTES = 8 * HTB, NXCD = 8, WGM = 4;

__host__ __device__ __forceinline__ int lds_byte(int r, int c) { const int st = (r >> 4) * 2 + (c >> 5), rr = r & 15, cc = c & 31, ob = rr * 64 + cc * 2; return st * 1024 + (ob ^ (((ob >> 9) & 1) << 5)); }
__host__ __device__ __forceinline__ void stage_rc(int b, int& R, int& C) { const int st = b / 1024, sb = b % 1024, swz = sb ^ (((sb >> 9) & 1) << 5); R = (st >> 1) * 16 + swz / 64; C = (st & 1) * 32 + (swz % 64) / 2; }
__host__ __device__ __forceinline__ int perm32(int rho) { const int n = rho >> 4, i = rho & 15; return 8 * (i >> 2) + 4 * n + (i & 3); }

struct Unit { int pm, pn; };
struct Gemm { const bf16_t* A; const bf16_t* Bt; int M, N, K; };

struct StaticOrder {
    int nM, nN, nwg, G, c;
    __host__ __device__ void init(int M, int N, int G_, int c_) { nM = M / BM; nN = N / BM; nwg = nM * nN; G = G_; c = c_; }
    __host__ __device__ bool next(int i, Unit& u) const {
        const long L = (long)i * G + c; if (L >= nwg) return false;
        int wgid = (int)L; { const int q = nwg / NXCD, r = nwg % NXCD, xcd = wgid % NXCD, off = wgid / NXCD; wgid = (xcd < r ? xcd * (q + 1) : r * (q + 1) + (xcd - r) * q) + off; }
        const int nig = WGM * nN, gid = wgid / nig, fm = gid * WGM, gsz = (nM - fm) < WGM ? (nM - fm) : WGM;
        u.pm = fm + ((wgid % nig) % gsz); u.pn = (wgid % nig) / gsz; return true;
    }
    __device__ __forceinline__ void a_ready(const Unit&) const {}
    __device__ __forceinline__ void done(const Unit&) const {}
};


typedef unsigned u32x4 __attribute__((ext_vector_type(4)));
__device__ __forceinline__ unsigned cvt_pk_bf16(float lo, float hi) { unsigned r; asm volatile("v_cvt_pk_bf16_f32 %0, %1, %2" : "=v"(r) : "v"(lo), "v"(hi)); return r; }
__device__ __forceinline__ u32x4 pack8(const f32x4 v0, const f32x4 v1) { u32x4 w; w.x = cvt_pk_bf16(v0[0], v0[1]); w.y = cvt_pk_bf16(v0[2], v0[3]); w.z = cvt_pk_bf16(v1[0], v1[1]); w.w = cvt_pk_bf16(v1[2], v1[3]); return w; }
__device__ __forceinline__ float sq4(const f32x4 v) { return (v[0] * v[0] + v[1] * v[1]) + (v[2] * v[2] + v[3] * v[3]); }
__device__ __forceinline__ float sum_x32(float v) { const auto r = __builtin_amdgcn_permlane32_swap(__builtin_bit_cast(unsigned, v), __builtin_bit_cast(unsigned, v), false, false); return __builtin_bit_cast(float, r[0]) + __builtin_bit_cast(float, r[1]); }
__device__ __forceinline__ float max_x32(float v) { const auto r = __builtin_amdgcn_permlane32_swap(__builtin_bit_cast(unsigned, v), __builtin_bit_cast(unsigned, v), false, false); return fmaxf(__builtin_bit_cast(float, r[0]), __builtin_bit_cast(float, r[1])); }
__device__ __forceinline__ float sum_fq(float v) { v += __shfl_xor(v, 16); v += __shfl_xor(v, 32); return v; }
__device__ __forceinline__ float max_fq(float v) { v = fmaxf(v, __shfl_xor(v, 16)); v = fmaxf(v, __shfl_xor(v, 32)); return v; }
constexpr float RMS_EPS = 1e-6f;

struct EpiProj {
    static constexpr bool PERM = true, AFTER_DRAIN = false;
    bf16_t* O; int ldc; const float* ssrow; float rdim_inv; float* ssh; int hs_stride; int h_lo, h_hi;
    bf16_t* KB; int kb_lo, kb_hi;
    __device__ __forceinline__ void operator()(const f32x4 (&acc)[2][2][4][2], const Unit& u, int wr, int wc, int fr, int fq) const {
        const int row0 = u.pm * BM + wr * 64 + fr, col0 = u.pn * BM + wc * 32 + 8 * fq;
        const bool heads = (ssh != nullptr) && u.pn >= h_lo && u.pn < h_hi;
        const int hbase = 2 * (u.pn - h_lo);
#pragma unroll
        for (int ai = 0; ai < 2; ++ai)
#pragma unroll
            for (int m = 0; m < 4; ++m) {
                const int row = row0 + ai * HALF + m * 16;
                float r = 1.f; if (ssrow) r = __builtin_amdgcn_rsqf(ssrow[row] * rdim_inv + RMS_EPS);
#pragma unroll
                for (int bj = 0; bj < 2; ++bj) {
                    const f32x4 v0 = acc[ai][bj][m][0] * r, v1 = acc[ai][bj][m][1] * r;
                    if (u.pn >= kb_lo && u.pn < kb_hi) { const int hh = 2 * (u.pn - kb_lo) + bj, dc = (wc * 32 + 8 * fq) >> 3;
                        *(u32x4*)(KB + ((((size_t)(row >> 6) * 8 + hh) * 8 + ((row & 63) >> 3)) * 16 + dc) * 64 + (row & 7) * 8) = pack8(v0, v1); }
                    else *(u32x4*)(O + (size_t)row * ldc + col0 + bj * HALF) = pack8(v0, v1);
                    if (heads) { float s = sq4(v0) + sq4(v1); s = sum_fq(s); if (fq == 0) atomicAdd(ssh + (size_t)(hbase + bj) * hs_stride + row, s); }
                }
            }
    }
};
struct EpiColScale {
    static constexpr bool PERM = true, AFTER_DRAIN = false;
    bf16_t* O; int tb_shift; int nh; const float* sscol; float rdim_inv;
    __device__ __forceinline__ void operator()(const f32x4 (&acc)[2][2][4][2], const Unit& u, int wr, int wc, int fr, int fq) const {
        typedef unsigned u32x2e __attribute__((ext_vector_type(2)));
        const int row0 = u.pm * BM + wr * 64 + fr, col0 = u.pn * BM + wc * 32 + 8 * fq;
        f32x4 rc[2][2];
#pragma unroll
        for (int bj = 0; bj < 2; ++bj)
#pragma unroll
            for (int n = 0; n < 2; ++n) {
                float one = 1.f; asm volatile("" : "+v"(one));
                rc[bj][n] = (f32x4){one, one, one, one};
                if (sscol) { const f32x4 s = *(const f32x4*)(sscol + col0 + bj * HALF + 4 * n);
#pragma unroll
                    for (int i = 0; i < 4; ++i) rc[bj][n][i] = __builtin_amdgcn_rsqf(s[i] * rdim_inv + RMS_EPS); }
            }
#pragma unroll
        for (int ai = 0; ai < 2; ++ai)
#pragma unroll
            for (int m = 0; m < 4; ++m) {
                const int row = row0 + ai * HALF + m * 16, h = row >> 7, d = row & 127;
#pragma unroll
                for (int bj = 0; bj < 2; ++bj) {
                    const int col = col0 + bj * HALF, blk = col >> tb_shift, kg = (col & ((1 << tb_shift) - 1)) >> 2;
                    const size_t e = ((size_t)(blk * nh + h) * (size_t)(1 << (tb_shift - 2)) + kg) * 512 + d * 4;
                    const u32x4 w = pack8(acc[ai][bj][m][0] * rc[bj][0], acc[ai][bj][m][1] * rc[bj][1]);
                    *(u32x2e*)(O + e) = (u32x2e){w.x, w.y}; *(u32x2e*)(O + e + 512) = (u32x2e){w.z, w.w};
                }
            }
    }
};
struct EpiResid {
    static constexpr bool PERM = true, AFTER_DRAIN = false;
    bf16_t* xb; float* xout; float* ssnext; int ldc;
    __device__ __forceinline__ void operator()(const f32x4 (&acc)[2][2][4][2], const Unit& u, int wr, int wc, int fr, int fq) const {
        const int row0 = u.pm * BM + wr * 64 + fr, col0 = u.pn * BM + wc * 32 + 8 * fq;
#pragma unroll
        for (int ai = 0; ai < 2; ++ai) {
            u32x4 res[4][2];
#pragma unroll
            for (int m = 0; m < 4; ++m)
#pragma unroll
                for (int bj = 0; bj < 2; ++bj) res[m][bj] = *(const u32x4*)(xb + (size_t)(row0 + ai * HALF + m * 16) * ldc + col0 + bj * HALF);
            __builtin_amdgcn_sched_barrier(0);
#pragma unroll
            for (int m = 0; m < 4; ++m) {
                const int row = row0 + ai * HALF + m * 16; float s = 0.f;
#pragma unroll
                for (int bj = 0; bj < 2; ++bj) {
                    const size_t p = (size_t)row * ldc + col0 + bj * HALF; const u32x4 rw = res[m][bj];
                    const f32x4 r0 = (f32x4){__builtin_bit_cast(float, rw.x << 16), __builtin_bit_cast(float, rw.x & 0xffff0000u), __builtin_bit_cast(float, rw.y << 16), __builtin_bit_cast(float, rw.y & 0xffff0000u)};
                    const f32x4 r1 = (f32x4){__builtin_bit_cast(float, rw.z << 16), __builtin_bit_cast(float, rw.z & 0xffff0000u), __builtin_bit_cast(float, rw.w << 16), __builtin_bit_cast(float, rw.w & 0xffff0000u)};
                    const f32x4 v0 = acc[ai][bj][m][0] + r0, v1 = acc[ai][bj][m][1] + r1;
                    if (xout) { *(f32x4*)(xout + p) = v0; *(f32x4*)(xout + p + 4) = v1; }
                    else { *(u32x4*)(xb + p) = pack8(v0, v1); s += sq4(v0) + sq4(v1); }
                }
                if (!xout) { s = sum_fq(s); if (fq == 0) atomicAdd(ssnext + row, s); }
            }
            asm volatile("" ::: "memory");
        }
    }
};
struct EpiSwiGLU {
    static constexpr bool PERM = true, AFTER_DRAIN = false;
    bf16_t* H; int ldh; const float* ssrow; float rdim_inv;
    __device__ __forceinline__ void operator()(const f32x4 (&acc)[2][2][4][2], const Unit& u, int wr, int wc, int fr, int fq) const {
        const int row0 = u.pm * BM + wr * 64 + fr, col0 = u.pn * HALF + wc * 32 + 8 * fq;
#pragma unroll
        for (int ai = 0; ai < 2; ++ai)
#pragma unroll
            for (int m = 0; m < 4; ++m) {
                const int row = row0 + ai * HALF + m * 16;
                const float r = __builtin_amdgcn_rsqf(ssrow[row] * rdim_inv + RMS_EPS);
                f32x4 h[2];
#pragma unroll
                for (int n = 0; n < 2; ++n) {
                    const f32x4 g = acc[ai][0][m][n] * r, up = acc[ai][1][m][n] * r;
#pragma unroll
                    for (int i = 0; i < 4; ++i) h[n][i] = g[i] * __builtin_amdgcn_rcpf(1.f + __expf(-g[i])) * up[i];
                }
                *(u32x4*)(H + (size_t)row * ldh + col0) = pack8(h[0], h[1]);
            }
    }
};
template <class Epi, class Sched, bool ALIGN_EPI = false, bool SP2 = false>
__device__ __forceinline__ void gemm_phase(PG8_LAS unsigned char* lds, const Gemm g, const Sched& S, const Epi& E, const int wave_in) {
    int tid_l; asm volatile("v_mbcnt_lo_u32_b32 %0, -1, 0\n\tv_mbcnt_hi_u32_b32 %0, -1, %0" : "=v"(tid_l)); tid_l += wave_in * 64;
    const int tid = tid_l, wid = __builtin_amdgcn_readfirstlane(tid >> 6), lane = tid & 63, wr = wid >> 2, wc = wid & 3, fr = lane & 15, fq = lane >> 4;
    const int K = g.K, nt = K / BK;
    unsigned voffA[2], voffB[2];
#pragma unroll
    for (int i = 0; i < 2; ++i) { int R, C; stage_rc(tid * 16 + i * 8192, R, C); const int Rb = Epi::PERM ? ((R & ~31) + perm32(R & 31)) : R;
        voffA[i] = (unsigned)(R * K + C) * 2u; voffB[i] = (unsigned)(Rb * K + C) * 2u; }
    const size_t kstep = (size_t)(BK * 2);
    const size_t hstep = (size_t)HALF * K * 2;
    const size_t tstep = 2 * hstep;
    const unsigned ldsw = (unsigned)wid * 1024u;
    const int aoff = lds_byte(wr * 64 + fr, fq * 8), boff = lds_byte(wc * 32 + fr, fq * 8);
#define PG8_SA(b, h) (((b) * 2 + (h)) * HTB)
#define PG8_SB(b, h) ((4 + (b) * 2 + (h)) * HTB)
#define PG8_STAGE(bufoff, gbase, voff) do { _Pragma("unroll") for (int _i = 0; _i < 2; ++_i) \
        __builtin_amdgcn_global_load_lds((const unsigned*)((const char*)(gbase) + (voff)[_i]), (PG8_LAS unsigned*)(lds + (bufoff) + ldsw + _i * 8192), 16, 0, 0); } while (0)
#define PG8_LDA(dst, b, h) do { _Pragma("unroll") for (int m = 0; m < 4; ++m) _Pragma("unroll") for (int k = 0; k < 2; ++k) dst[m][k] = *(const PG8_LAS bf16x8*)(lds + PG8_SA(b, h) + aoff + m * 2048 + k * 1024); } while (0)
#define PG8_LDB(dst, b, h) do { _Pragma("unroll") for (int n = 0; n < 2; ++n) _Pragma("unroll") for (int k = 0; k < 2; ++k) dst[n][k] = *(const PG8_LAS bf16x8*)(lds + PG8_SB(b, h) + boff + n * 2048 + k * 1024); } while (0)
#define PG8_MMA(ai, bj, At, Bt) do { __builtin_amdgcn_s_setprio(1); _Pragma("unroll") for (int m = 0; m < 4; ++m) _Pragma("unroll") for (int n = 0; n < 2; ++n) _Pragma("unroll") for (int k = 0; k < 2; ++k) \
        acc[ai][bj][m][n] = __builtin_amdgcn_mfma_f32_16x16x32_bf16(Bt[n][k], At[m][k], acc[ai][bj][m][n], 0, 0, 0); __builtin_amdgcn_s_setprio(0); } while (0)
#define PG8_WAIT_V(n) asm volatile("s_waitcnt vmcnt(" #n ")" ::: "memory")
#define PG8_WAIT_L(n) asm volatile("s_waitcnt lgkmcnt(" #n ")" ::: "memory")
#define PG8_BAR __builtin_amdgcn_s_barrier()
#define PG8_SCHED __builtin_amdgcn_sched_barrier(0)
    Unit cur, nxt; int ui = 0;
    if (!S.next(0, cur)) return;
    f32x4 acc[2][2][4][2];
#pragma unroll
    for (int a = 0; a < 2; ++a)
#pragma unroll
        for (int b = 0; b < 2; ++b)
#pragma unroll
            for (int m = 0; m < 4; ++m)
#pragma unroll
                for (int n = 0; n < 2; ++n) acc[a][b][m][n] = (f32x4){0.f, 0.f, 0.f, 0.f};
    bf16x8 At[4][2], B0[2][2], B1[2][2];
    const char* cA = (const char*)g.A + (size_t)cur.pm * tstep; const char* cB = (const char*)g.Bt + (size_t)cur.pn * tstep;
    S.a_ready(cur);
    if constexpr (SP2) {
        PG8_STAGE(PG8_SB(0, 0), cB, voffB); PG8_STAGE(PG8_SB(0, 1), cB + hstep, voffB); PG8_STAGE(PG8_SA(0, 0), cA, voffA); PG8_STAGE(PG8_SA(0, 1), cA + hstep, voffA);
        if (wr == 1) PG8_BAR;
        PG8_WAIT_V(2); PG8_BAR;
        PG8_STAGE(PG8_SB(1, 0), cB + kstep, voffB); PG8_STAGE(PG8_SA(1, 0), cA + kstep, voffA); PG8_STAGE(PG8_SB(1, 1), cB + hstep + kstep, voffB);
        PG8_WAIT_V(6); PG8_BAR;
    } else {
        PG8_STAGE(PG8_SB(0, 0), cB, voffB); PG8_STAGE(PG8_SA(0, 0), cA, voffA); PG8_STAGE(PG8_SB(0, 1), cB + hstep, voffB); PG8_STAGE(PG8_SA(0, 1), cA + hstep, voffA);
        if (wr == 1) PG8_BAR;
        PG8_WAIT_V(4); PG8_BAR;
        PG8_STAGE(PG8_SB(1, 0), cB + kstep, voffB); PG8_STAGE(PG8_SA(1, 0), cA + kstep, voffA); PG8_STAGE(PG8_SB(1, 1), cB + hstep + kstep, voffB);
        PG8_WAIT_V(6); PG8_BAR;
    }
    for (;;) {
        const bool has_next = S.next(ui + 1, nxt);
        const char* nA = has_next ? (const char*)g.A + (size_t)nxt.pm * tstep : cA; const char* nB = has_next ? (const char*)g.Bt + (size_t)nxt.pn * tstep : cB;
        for (int t = 0; t < nt; t += 2) {
            const bool last = (t == nt - 2);
            const char* a1 = cA + (size_t)(t + 1) * kstep;
            const char* a2 = last ? nA : cA + (size_t)(t + 2) * kstep; const char* b2 = last ? nB : cB + (size_t)(t + 2) * kstep;
            const char* a3 = a2 + kstep; const char* b3 = b2 + kstep;
            if (last && has_next) S.a_ready(nxt);
            if constexpr (SP2) {
            PG8_LDB(B0, 0, 0); PG8_LDB(B1, 0, 1); PG8_SCHED; PG8_LDA(At, 0, 0); PG8_STAGE(PG8_SA(1, 1), a1 + hstep, voffA);
            PG8_WAIT_V(8); PG8_WAIT_L(0); PG8_BAR; PG8_MMA(0, 0, At, B0); PG8_MMA(0, 1, At, B1); PG8_BAR; PG8_SCHED;
            PG8_LDA(At, 0, 1); PG8_STAGE(PG8_SB(0, 0), b2, voffB); PG8_STAGE(PG8_SB(0, 1), b2 + hstep, voffB); PG8_STAGE(PG8_SA(0, 0), a2, voffA);
            PG8_WAIT_V(8); PG8_WAIT_L(0); PG8_BAR; PG8_MMA(1, 0, At, B0); PG8_MMA(1, 1, At, B1); PG8_BAR; PG8_SCHED;
            PG8_LDB(B0, 1, 0); PG8_LDB(B1, 1, 1); PG8_SCHED; PG8_LDA(At, 1, 0); PG8_STAGE(PG8_SA(0, 1), a2 + hstep, voffA);
            PG8_WAIT_V(8); PG8_WAIT_L(0); PG8_BAR; PG8_MMA(0, 0, At, B0); PG8_MMA(0, 1, At, B1); PG8_BAR; PG8_SCHED;
            PG8_LDA(At, 1, 1); PG8_STAGE(PG8_SB(1, 0), b3, voffB); PG8_STAGE(PG8_SB(1, 1), b3 + hstep, voffB); PG8_STAGE(PG8_SA(1, 0), a3, voffA);
            PG8_WAIT_V(8); PG8_WAIT_L(0); PG8_BAR; PG8_MMA(1, 0, At, B0); PG8_MMA(1, 1, At, B1); PG8_BAR; PG8_SCHED;
            } else {
            PG8_LDB(B0, 0, 0); PG8_SCHED; PG8_LDA(At, 0, 0); PG8_STAGE(PG8_SA(1, 1), a1 + hstep, voffA);
            PG8_WAIT_L(8); PG8_BAR; PG8_WAIT_L(0); PG8_MMA(0, 0, At, B0); PG8_BAR; PG8_SCHED;
            PG8_LDB(B1, 0, 1); PG8_STAGE(PG8_SB(0, 0), b2, voffB);
            PG8_BAR; PG8_WAIT_L(0); PG8_MMA(0, 1, At, B1); PG8_BAR;
            PG8_LDA(At, 0, 1); PG8_STAGE(PG8_SA(0, 0), a2, voffA);
            PG8_BAR; PG8_WAIT_L(0); PG8_MMA(1, 0, At, B0); PG8_BAR; PG8_SCHED;
            PG8_STAGE(PG8_SB(0, 1), b2 + hstep, voffB);
            PG8_WAIT_V(6); PG8_BAR; PG8_MMA(1, 1, At, B1); PG8_BAR;
            PG8_LDB(B0, 1, 0); PG8_SCHED; PG8_LDA(At, 1, 0); PG8_STAGE(PG8_SA(0, 1), a2 + hstep, voffA);
            PG8_WAIT_L(8); PG8_BAR; PG8_WAIT_L(0); PG8_MMA(0, 0, At, B0); PG8_BAR; PG8_SCHED;
            PG8_LDB(B1, 1, 1); PG8_STAGE(PG8_SB(1, 0), b3, voffB);
            PG8_BAR; PG8_WAIT_L(0); PG8_MMA(0, 1, At, B1); PG8_BAR;
            PG8_LDA(At, 1, 1); PG8_STAGE(PG8_SA(1, 0), a3, voffA);
            PG8_BAR; PG8_WAIT_L(0); PG8_MMA(1, 0, At, B0); PG8_BAR; PG8_SCHED;
            PG8_STAGE(PG8_SB(1, 1), b3 + hstep, voffB);
            PG8_WAIT_V(6); PG8_BAR; PG8_MMA(1, 1, At, B1); PG8_BAR;
            }
        }
        if constexpr (ALIGN_EPI) { if (wr == 0) PG8_BAR; }
        if constexpr (!Epi::AFTER_DRAIN) { E(acc, cur, wr, wc, fr, fq); S.done(cur); }
        if (!has_next) break;
#pragma unroll
        for (int a = 0; a < 2; ++a)
#pragma unroll
            for (int b = 0; b < 2; ++b)
#pragma unroll
                for (int m = 0; m < 4; ++m)
#pragma unroll
                    for (int n = 0; n < 2; ++n) acc[a][b][m][n] = (f32x4){0.f, 0.f, 0.f, 0.f};
        cur = nxt; cA = nA; cB = nB; ++ui;
        if constexpr (ALIGN_EPI) { if (wr == 1) PG8_BAR; }
    }
    PG8_WAIT_V(0);
    if constexpr (!ALIGN_EPI) { if (wr == 0) PG8_BAR; }
    PG8_BAR;
    if constexpr (Epi::AFTER_DRAIN) { E.fused(acc, cur, wr, wc, fr, fq, lds, wid, lane); S.done(cur); }
#undef PG8_SA
#undef PG8_SB
#undef PG8_STAGE
#undef PG8_LDA
#undef PG8_LDB
#undef PG8_MMA
#undef PG8_WAIT_V
#undef PG8_WAIT_L
#undef PG8_BAR
#undef PG8_SCHED
}
}

#ifndef PG8_SP2
#define PG8_SP2 true
#endif
#ifndef PG8_ALIGN
#define PG8_ALIGN true
#endif
#ifndef NPRO
#define NPRO 1
#endif
#ifndef LSEQ
#define LSEQ 0x543210ull
#define LSEQ_N 6
#endif
#ifndef MK_LAUNCHES
#define MK_LAUNCHES 1
#endif

using pg8::bf16_t; using pg8::bf16x8; using pg8::f32x4; using pg8::u32x4;
typedef unsigned u32x2 __attribute__((ext_vector_type(2)));
#define GAS __attribute__((address_space(1)))
#define LAS __attribute__((address_space(3)))
constexpr int NWAVES = 8;
constexpr int BATCH = 4, SEQ = 8192, DM = 2048, NTOK = BATCH * SEQ, DIN = 4096, DFF = 5632, NMEM = 256, HD = 128;
constexpr int PROJ_W = 3072;
constexpr int NPH = NPRO + 2 * LSEQ_N;
constexpr float EPS = 1e-6f;
constexpr float ATT_SCALE = 0.08838834764831845f;

constexpr size_t MiB = 1u << 20;
constexpr size_t WS_SS = 1 * MiB;
constexpr size_t SS_X = 0, SS_H = 5 * (size_t)NTOK, SS_MK = SS_H + 2 * 20 * (size_t)NTOK, SS_END = SS_MK + 2 * 4 * 1024;
constexpr size_t WS_TAB = 9 * MiB;
constexpr size_t TAB_T64 = 0, TAB_T128 = 16 * 1024, TAB_MT = 128 * 1024, TAB_GQK = 768 * 1024, TAB_RPB = 800 * 1024;
constexpr size_t WS_WIN = 10 * MiB, WS_WOUT = 42 * MiB, WS_WGU = 58 * MiB, WS_WDN = 146 * MiB, WS_WMKV = 190 * MiB;
constexpr size_t WS_MEMB = 198 * MiB, WS_KM = 202 * MiB, WS_VMT = 204 * MiB, WS_XB = 206 * MiB;
constexpr size_t WS_PROJ = 334 * MiB, WS_VT = 526 * MiB, WS_Y = 590 * MiB, WS_A2 = 718 * MiB, WS_H = 334 * MiB, WS_KB = 782 * MiB, WS_END = 846 * MiB;
static_assert(SS_END * 4 <= 8 * MiB, "ss region");
static_assert(WS_H + (size_t)NTOK * DFF * 2 <= WS_A2, "hidden overlays proj | VT | y only");

constexpr int RING_BYTES = 131072, LDS_BYTES = 147456;

__device__ __forceinline__ float wave_sum(float v) {
#pragma unroll
    for (int o = 1; o < 64; o <<= 1) v += __shfl_xor(v, o);
    return v;
}
__device__ __forceinline__ float bf2f(unsigned short b) { return __builtin_bit_cast(float, (unsigned)b << 16); }
__device__ __forceinline__ float cos_rev(float x) { return __builtin_amdgcn_cosf(x); }
__device__ __forceinline__ float sin_rev(float x) { return __builtin_amdgcn_sinf(x); }
#define MFMA16(a, b, c) __builtin_amdgcn_mfma_f32_16x16x32_bf16((a), (b), (c), 0, 0, 0)
#define CFENCE() asm volatile("" ::: "memory")

struct Args { const float* in[18]; float* out; unsigned char* ws; int ph_lo, ph_hi; };

struct TrItem { const float* W; const float* gain; bf16_t* WT; int N, K, k0, n0, drow; };
__device__ __forceinline__ TrItem tr_decode(const Args& a, unsigned char* ws, int it) {
    constexpr int I_IN = 32 * 128, I_OUT = 32 * 64, I_G = 32 * 176, I_D = 88 * 64, I_MKV = 32 * 32, I_L = I_IN + I_OUT + 2 * I_G + I_D + I_MKV;
    const int l = it / I_L; int r = it % I_L; TrItem d;
    if (r < I_IN) { const int kb = r / 128, nb = r % 128, n0 = 32 * nb;
        d.W = a.in[3] + (size_t)l * DM * DIN; d.gain = a.in[2] + l * DM; d.WT = (bf16_t*)(ws + WS_WIN) + (size_t)l * DIN * DM; d.N = DIN; d.K = DM; d.k0 = 64 * kb; d.n0 = n0;
        d.drow = n0 + ((n0 < 2048) ? 0 : (n0 < 3072 ? 1024 : -1024)); return d; }
    r -= I_IN;
    if (r < I_OUT) { const int kb = r / 64, nb = r % 64;
        d.W = a.in[13] + (size_t)l * DM * DM; d.gain = a.in[12] + l * DM; d.WT = (bf16_t*)(ws + WS_WOUT) + (size_t)l * DM * DM; d.N = DM; d.K = DM; d.k0 = 64 * kb; d.n0 = 32 * nb; d.drow = 32 * nb; return d; }
    r -= I_OUT;
    if (r < 2 * I_G) { const int up = r >= I_G; if (up) r -= I_G; const int kb = r / 176, nb = r % 176, n0 = 32 * nb;
        d.W = a.in[up ? 16 : 15] + (size_t)l * DM * DFF; d.gain = a.in[14] + l * DM; d.WT = (bf16_t*)(ws + WS_WGU) + (size_t)l * 2 * DFF * DM; d.N = DFF; d.K = DM; d.k0 = 64 * kb; d.n0 = n0;
        d.drow = (n0 >> 7) * 256 + (n0 & 127) + (up ? 128 : 0); return d; }
    r -= 2 * I_G;
    if (r < I_D) { const int kb = r / 64, nb = r % 64;
        d.W = a.in[17] + (size_t)l * DFF * DM; d.gain = nullptr; d.WT = (bf16_t*)(ws + WS_WDN) + (size_t)l * DM * DFF; d.N = DM; d.K = DFF; d.k0 = 64 * kb; d.n0 = 32 * nb; d.drow = 32 * nb; return d; }
    r -= I_D;
    { const int kb = r / 32, nb = r % 32;
        d.W = a.in[9] + (size_t)l * DM * 1024; d.gain = a.in[8] + l * DM; d.WT = (bf16_t*)(ws + WS_WMKV) + (size_t)l * 1024 * DM; d.N = 1024; d.K = DM; d.k0 = 64 * kb; d.n0 = 32 * nb; d.drow = 32 * nb; return d; }
}
__device__ __forceinline__ void tr_load(const TrItem& d, float (&v)[32], int lane) {
    const float* src = d.W + (size_t)(d.k0 + (lane >> 5)) * d.N + d.n0 + (lane & 31);
#pragma unroll
    for (int i = 0; i < 32; ++i) v[i] = src[(size_t)(2 * i) * d.N];
}
__device__ __forceinline__ void tr_store(const TrItem& d, const float (&v)[32], LAS float* scr, int lane) {
#pragma unroll
    for (int i = 0; i < 32; ++i) { const int kk = 2 * i + (lane >> 5); const float gk = d.gain ? d.gain[d.k0 + kk] : 1.f; scr[kk * 33 + (lane & 31)] = v[i] * gk; }
    asm volatile("s_waitcnt lgkmcnt(0)" ::: "memory");
    const int c = lane & 7;
#pragma unroll
    for (int j = 0; j < 4; ++j) { const int n = (lane >> 3) + 8 * j; const LAS float* s = scr + (8 * c) * 33 + n;
        u32x4 o; o.x = pg8::cvt_pk_bf16(s[0 * 33], s[1 * 33]); o.y = pg8::cvt_pk_bf16(s[2 * 33], s[3 * 33]); o.z = pg8::cvt_pk_bf16(s[4 * 33], s[5 * 33]); o.w = pg8::cvt_pk_bf16(s[6 * 33], s[7 * 33]);
        *(u32x4*)(d.WT + (size_t)(d.drow + n) * d.K + d.k0 + 8 * c) = o; }
    asm volatile("s_waitcnt lgkmcnt(0)" ::: "memory");
}

__device__ __forceinline__ void prologue(const Args& a, unsigned char* ws, LAS unsigned char* lds, int tid, int lane, int wave, int vcu, int G) {
    LAS float* scr = (LAS float*)(lds + wave * 16384);
    const int gw = vcu * NWAVES + wave, NGW = G * NWAVES;
    constexpr int N_ITEMS = 2 * (32 * 128 + 32 * 64 + 2 * 32 * 176 + 88 * 64 + 32 * 32);
    if (gw < N_ITEMS) {
        float cur[32], nxt[32];
        TrItem dc = tr_decode(a, ws, gw);
        tr_load(dc, cur, lane);
#pragma unroll 1
        for (int it = gw; it < N_ITEMS; it += NGW) {
            const int itn = it + NGW; const bool more = itn < N_ITEMS;
            TrItem dn = tr_decode(a, ws, more ? itn : it);
            if (more) tr_load(dn, nxt, lane);
            tr_store(dc, cur, scr, lane);
#pragma unroll
            for (int i = 0; i < 32; ++i) cur[i] = nxt[i];
            dc = dn;
        }
    }
    float* ss = (float*)(ws + WS_SS);
    for (int m = gw; m < NTOK + BATCH * NMEM; m += NGW) {
        const bool ismem = m >= NTOK; const int row = ismem ? m - NTOK : m;
        const f32x4* xr = (const f32x4*)((ismem ? a.in[1] : a.in[0]) + (size_t)row * DM) + lane;
        f32x4 v[8]; float s = 0.f;
#pragma unroll
        for (int j = 0; j < 8; ++j) { v[j] = xr[64 * j]; s += pg8::sq4(v[j]); }
        s = wave_sum(s);
        float sc = 1.f;
        if (ismem) sc = __builtin_amdgcn_rsqf(s * (1.f / DM) + EPS); else if (lane == 0) ss[SS_X + row] = s;
        u32x2* o = (u32x2*)((bf16_t*)(ws + (ismem ? WS_MEMB : WS_XB)) + (size_t)row * DM) + lane;
#pragma unroll
        for (int j = 0; j < 8; ++j) { u32x2 w; w.x = pg8::cvt_pk_bf16(v[j][0] * sc, v[j][1] * sc); w.y = pg8::cvt_pk_bf16(v[j][2] * sc, v[j][3] * sc); o[64 * j] = w; }
    }
    const int gt = vcu * (NWAVES * 64) + tid, NT = G * NWAVES * 64;
    { float z = 0.f; asm volatile("" : "+v"(z));
      for (size_t i = (size_t)NTOK / 4 + gt; i < SS_END / 4; i += NT) ((f32x4*)ss)[i] = (f32x4){z, z, z, z}; }
    bf16_t* T64 = (bf16_t*)(ws + WS_TAB + TAB_T64); bf16_t* T128 = (bf16_t*)(ws + WS_TAB + TAB_T128); bf16_t* MT = (bf16_t*)(ws + WS_TAB + TAB_MT); float* GQK = (float*)(ws + WS_TAB + TAB_GQK);
    for (int i = gt; i < 128 * 64; i += NT) { const int m = i >> 6, s1 = i & 63, k1 = m & 63; const float fr = (float)((k1 * s1) & 63) * (1.f / 64.f);
        const float v = (m < 64) ? cos_rev(fr) : -sin_rev(fr); T64[i] = (bf16_t)(pg8::cvt_pk_bf16(v, 0.f) & 0xffffu); }
    for (int i = gt; i < 3 * 128 * 128; i += NT) { const int p = i >> 14, k2 = (i >> 7) & 127, s2 = i & 127; const float fr = (float)((k2 * s2) & 127) * (1.f / 128.f);
        const float v = (p == 0) ? cos_rev(fr) : (p == 1 ? -sin_rev(fr) : sin_rev(fr)); T128[i] = (bf16_t)(pg8::cvt_pk_bf16(v, 0.f) & 0xffffu); }
    { float* RPB = (float*)(ws + WS_TAB + TAB_RPB); for (int i = gt; i < 2 * 8 * 15 * 31; i += NT) RPB[i] = a.in[6][i]; }
    for (int i = gt; i < 2 * 2 * 128; i += NT) { const int d = i & 127, kind = (i >> 7) & 1, l = i >> 8;
        GQK[i] = (kind == 0 ? a.in[4][l * HD + d] * a.in[5][l * HD + d] : a.in[10][l * HD + d] * a.in[11][l * HD + d]) * ATT_SCALE; }
    for (int i = gt; i < 2 * 4 * 256 * 128; i += NT) { const int e = i & 127, c2 = (i >> 7) & 255, lg = i >> 15, c = c2 & 127, im = c2 >> 7;
        const float* wf = a.in[7] + (size_t)lg * 128 * 128 + e; float acc = 0.f;
#pragma unroll 16
        for (int cp = 0; cp < 128; ++cp) { const float fr = (float)((c * cp) & 127) * (1.f / 128.f); const float t = im ? sin_rev(fr) : cos_rev(fr); acc += t * wf[cp * 128]; }
        MT[((((size_t)lg * 8 + (c2 >> 5)) * 4 + ((c2 >> 2) & 3)) * 128 + e) * 8 + ((c2 >> 4) & 1) * 4 + (c2 & 3)] = (bf16_t)(pg8::cvt_pk_bf16(acc * (1.f / 1024.f), 0.f) & 0xffffu); }
}

typedef __amdgpu_buffer_rsrc_t rsrc_t;
__device__ __forceinline__ rsrc_t make_rsrc(void* p) { return __builtin_amdgcn_make_buffer_rsrc(p, 0, 0x7fffffff, 0x00020000); }
template <class T> __device__ __forceinline__ T bld(rsrc_t r, unsigned voff, unsigned soff) {
    if constexpr (sizeof(T) == 16) { const u32x4 v = __builtin_amdgcn_raw_buffer_load_b128(r, voff, soff, 0); return __builtin_bit_cast(T, v); }
    else if constexpr (sizeof(T) == 8) { const u32x2 v = __builtin_amdgcn_raw_buffer_load_b64(r, voff, soff, 0); return __builtin_bit_cast(T, v); }
    else if constexpr (sizeof(T) == 4) { const unsigned v = __builtin_amdgcn_raw_buffer_load_b32(r, voff, soff, 0); return __builtin_bit_cast(T, v); }
    else { const unsigned short v = __builtin_amdgcn_raw_buffer_load_b16(r, voff, soff, 0); return __builtin_bit_cast(T, v); }
}
template <class T> __device__ __forceinline__ void bst(rsrc_t r, unsigned voff, unsigned soff, T v) {
    if constexpr (sizeof(T) == 16) __builtin_amdgcn_raw_buffer_store_b128(__builtin_bit_cast(u32x4, v), r, voff, soff, 0);
    else if constexpr (sizeof(T) == 8) __builtin_amdgcn_raw_buffer_store_b64(__builtin_bit_cast(u32x2, v), r, voff, soff, 0);
    else if constexpr (sizeof(T) == 4) __builtin_amdgcn_raw_buffer_store_b32(__builtin_bit_cast(unsigned, v), r, voff, soff, 0);
    else __builtin_amdgcn_raw_buffer_store_b16(__builtin_bit_cast(unsigned short, v), r, voff, soff, 0);
}
#define SCHED_FENCE() __builtin_amdgcn_sched_barrier(0)
typedef short v4i16_t __attribute__((ext_vector_type(4)));
constexpr unsigned OFF_T64 = (unsigned)(WS_TAB + TAB_T64), OFF_T128 = (unsigned)(WS_TAB + TAB_T128), OFF_MT = (unsigned)(WS_TAB + TAB_MT), OFF_GQK = (unsigned)(WS_TAB + TAB_GQK), OFF_RPB = (unsigned)(WS_TAB + TAB_RPB);
constexpr unsigned OFF_PROJ = (unsigned)WS_PROJ, OFF_VT = (unsigned)WS_VT, OFF_Y = (unsigned)WS_Y, OFF_A2R = (unsigned)WS_A2, OFF_A2I = (unsigned)(WS_A2 + 32 * MiB), OFF_KM = (unsigned)WS_KM, OFF_VMT = (unsigned)WS_VMT, OFF_SS = (unsigned)WS_SS;

__device__ __forceinline__ void fourier_stage_a(rsrc_t R, int it, int lane) {
    const int bg = it >> 7, s2 = it & 127, b = bg >> 2, g = bg & 3, n = lane & 15, kq = lane >> 4;
    bf16x8 wA[8][2];
    { const unsigned wo = (unsigned)(n * 64 + 8 * kq) * 2u;
#pragma unroll
      for (int mt = 0; mt < 8; ++mt)
#pragma unroll
        for (int ks = 0; ks < 2; ++ks) wA[mt][ks] = bld<bf16x8>(R, wo, OFF_T64 + (16 * mt * 64 + 32 * ks) * 2); }
    float tcs[16], tsn[16];
#pragma unroll
    for (int q = 0; q < 16; ++q) { const int k1 = 16 * (q >> 2) + 4 * kq + (q & 3); const float fr = (float)((s2 * k1) & 8191) * (1.f / 8192.f); tcs[q] = cos_rev(fr); tsn[q] = sin_rev(fr); }
    const unsigned ub = OFF_PROJ + (unsigned)(((b * SEQ + s2) * PROJ_W + 2048 + g * HD) * 2);
    const unsigned uo = (unsigned)(2 * n + kq * (8 * 128 * PROJ_W)) * 2u;
    const unsigned so = (unsigned)(kq * 4 * 16384 + 2 * n) * 2u;
    const unsigned ab = (unsigned)((bg * 64 * 128 + s2) * 128) * 2u;
    unsigned cur[16], nxt[16];
#pragma unroll
    for (int q = 0; q < 16; ++q) cur[q] = bld<unsigned>(R, uo, ub + (unsigned)((32 * (q >> 3) + (q & 7)) * (128 * PROJ_W)) * 2u);
#pragma unroll 1
    for (int ctp = 0; ctp < 4; ++ctp) {
        const int ctn = ctp < 3 ? ctp + 1 : 3;
#pragma unroll
        for (int q = 0; q < 16; ++q) nxt[q] = bld<unsigned>(R, uo, ub + (unsigned)((32 * (q >> 3) + (q & 7)) * (128 * PROJ_W) + 32 * ctn) * 2u);
        SCHED_FENCE();
        bf16x8 be[2], bo[2];
#pragma unroll
        for (int q = 0; q < 16; ++q) { be[q >> 3][q & 7] = (short)(cur[q] & 0xffffu); bo[q >> 3][q & 7] = (short)(cur[q] >> 16); }
        f32x4 ae[8], ao[8];
#pragma unroll
        for (int mt = 0; mt < 8; ++mt) { ae[mt] = (f32x4){0.f, 0.f, 0.f, 0.f}; ao[mt] = (f32x4){0.f, 0.f, 0.f, 0.f};
#pragma unroll
            for (int ks = 0; ks < 2; ++ks) { ae[mt] = MFMA16(wA[mt][ks], be[ks], ae[mt]); ao[mt] = MFMA16(wA[mt][ks], bo[ks], ao[mt]); } }
#pragma unroll
        for (int mt = 0; mt < 4; ++mt)
#pragma unroll
            for (int j = 0; j < 4; ++j) {
                const float cs = tcs[mt * 4 + j], sn = tsn[mt * 4 + j];
                const float ree = ae[mt][j], ime = ae[mt + 4][j], reo = ao[mt][j], imo = ao[mt + 4][j];
                const unsigned wr = pg8::cvt_pk_bf16(ree * cs + ime * sn, reo * cs + imo * sn);
                const unsigned wi = pg8::cvt_pk_bf16(ime * cs - ree * sn, imo * cs - reo * sn);
                const unsigned o = ab + (unsigned)((16 * mt + j) * 16384 + 32 * ctp) * 2u;
                bst<unsigned>(R, so, OFF_A2R + o, wr); bst<unsigned>(R, so, OFF_A2I + o, wi);
            }
        SCHED_FENCE();
#pragma unroll
        for (int q = 0; q < 16; ++q) cur[q] = nxt[q];
    }
}

constexpr int SLAB_ROWB = 288, SLAB_PLANE = 128 * SLAB_ROWB, MT_LDS = 2 * SLAB_PLANE;
static_assert(MT_LDS + 65536 <= LDS_BYTES - 64, "stage C LDS map (the grid barrier's words sit in the last 64 bytes)");
__device__ __forceinline__ void fourier_stage_c_block(LAS unsigned char* lds, rsrc_t R, int l, int bx, int G, int tid, int lane, int wave) {
    const int k2t = wave, n = lane & 15, kq = lane >> 4;
    const int upb = (16 * 64 + G - 1) / G, u_lo = bx * upb, u_hi = (u_lo + upb < 16 * 64) ? u_lo + upb : 16 * 64;
    if (u_lo >= u_hi) return;
    bf16x8 wr[4], wi[4], nwi[4];
    { const unsigned wo = (unsigned)(n * 128 + 8 * kq) * 2u; const unsigned tb = OFF_T128 + (unsigned)(16 * k2t * 128) * 2u;
#pragma unroll
      for (int ks = 0; ks < 4; ++ks) { wr[ks] = bld<bf16x8>(R, wo, tb + 64 * ks); wi[ks] = bld<bf16x8>(R, wo, tb + 32768 + 64 * ks); nwi[ks] = bld<bf16x8>(R, wo, tb + 65536 + 64 * ks); } }
    const int trbase = (8 * kq + ((lane & 15) >> 2)) * SLAB_ROWB + 8 * (lane & 3);
    const unsigned fo = (unsigned)tid * 16u;
    const int frow = tid >> 4, fch = tid & 15;
    int mlo = MT_LDS + n * 16 + kq * 2048;
    asm volatile("" : "+v"(mlo));
    const unsigned yo = (unsigned)(64 * n * DM + 4 * kq) * 2u;
    int g_lds = -1;
    u32x4 v[8];
    { const unsigned sb = (unsigned)u_lo * (128 * 128 * 2);
#pragma unroll
      for (int i = 0; i < 8; ++i) v[i] = bld<u32x4>(R, fo, ((i < 4) ? OFF_A2R : OFF_A2I) + sb + (unsigned)(i & 3) * 8192u); }
#pragma unroll 1
    for (int u = u_lo; u < u_hi; ++u) {
        const int k1 = u & 63, bg = u >> 6, b = bg >> 2, g = bg & 3;
        if (g != g_lds) {
            const unsigned mb = OFF_MT + (unsigned)((l * 4 + g) * 128 * 256) * 2u;
#pragma unroll
            for (int i = 0; i < 8; ++i) { const u32x4 mv = bld<u32x4>(R, fo, mb + (unsigned)i * 8192u); *(LAS u32x4*)(lds + MT_LDS + i * 8192 + tid * 16) = mv; }
            g_lds = g;
        }
#pragma unroll
        for (int i = 0; i < 8; ++i) *(LAS u32x4*)(lds + (i < 4 ? 0 : SLAB_PLANE) + (frow + 32 * (i & 3)) * SLAB_ROWB + fch * 16) = v[i];
        __syncthreads();
        if (u + 1 < u_hi) { const unsigned sb = (unsigned)(u + 1) * (128 * 128 * 2);
#pragma unroll
            for (int i = 0; i < 8; ++i) v[i] = bld<u32x4>(R, fo, ((i < 4) ? OFF_A2R : OFF_A2I) + sb + (unsigned)(i & 3) * 8192u); }
        f32x4 zr[8], zi[8];
#pragma unroll
        for (int ct = 0; ct < 8; ++ct) { zr[ct] = (f32x4){0.f, 0.f, 0.f, 0.f}; zi[ct] = (f32x4){0.f, 0.f, 0.f, 0.f}; }
#pragma unroll
        for (int ks = 0; ks < 4; ++ks) {
#pragma unroll
            for (int ct = 0; ct < 8; ++ct) {
                const LAS unsigned char* p = lds + trbase + (32 * ks) * SLAB_ROWB + 32 * ct;
                const v4i16_t r0 = __builtin_amdgcn_ds_read_tr16_b64_v4i16((LAS v4i16_t*)p), r1 = __builtin_amdgcn_ds_read_tr16_b64_v4i16((LAS v4i16_t*)(p + 4 * SLAB_ROWB));
                const v4i16_t i0 = __builtin_amdgcn_ds_read_tr16_b64_v4i16((LAS v4i16_t*)(p + SLAB_PLANE)), i1 = __builtin_amdgcn_ds_read_tr16_b64_v4i16((LAS v4i16_t*)(p + SLAB_PLANE + 4 * SLAB_ROWB));
                const bf16x8 ar = (bf16x8){r0[0], r0[1], r0[2], r0[3], r1[0], r1[1], r1[2], r1[3]}, ai = (bf16x8){i0[0], i0[1], i0[2], i0[3], i1[0], i1[1], i1[2], i1[3]};
                zr[ct] = MFMA16(ar, wr[ks], zr[ct]); zr[ct] = MFMA16(ai, nwi[ks], zr[ct]);
                zi[ct] = MFMA16(ar, wi[ks], zi[ct]); zi[ct] = MFMA16(ai, wr[ks], zi[ct]); }
        }
        f32x4 yv[8];
#pragma unroll
        for (int et = 0; et < 8; ++et) yv[et] = (f32x4){0.f, 0.f, 0.f, 0.f};
        SCHED_FENCE();
#pragma unroll
        for (int kx = 0; kx < 8; ++kx) {
            const int t0 = 2 * (kx & 3), t1 = t0 + 1, cb = (kx >> 2) * 128;
            const f32x4 z0 = (kx < 4) ? zr[t0] : zi[t0], z1 = (kx < 4) ? zr[t1] : zi[t1];
            const u32x4 bw = pg8::pack8(z0, z1); const bf16x8 bfr = __builtin_bit_cast(bf16x8, bw);
#pragma unroll
            for (int et = 0; et < 8; ++et) {
                const u32x4 aw = *(const LAS u32x4*)(lds + mlo + kx * 8192 + et * 256);
                yv[et] = MFMA16(__builtin_bit_cast(bf16x8, aw), bfr, yv[et]); }
            SCHED_FENCE();
        }
        float s = 0.f;
#pragma unroll
        for (int et = 0; et < 8; ++et) s += pg8::sq4(yv[et]);
        s = pg8::sum_fq(s);
        const float rn = __builtin_amdgcn_rsqf(s * (1.f / HD) + EPS);
        const unsigned yb = OFF_Y + (unsigned)((b * SEQ + k1 + 64 * 16 * k2t) * DM + 1024 + g * HD) * 2u;
#pragma unroll
        for (int et = 0; et < 8; ++et) { u32x2 w; w.x = pg8::cvt_pk_bf16(yv[et][0] * rn, yv[et][1] * rn); w.y = pg8::cvt_pk_bf16(yv[et][2] * rn, yv[et][3] * rn); bst<u32x2>(R, yo, yb + 32 * et, w); }
        __syncthreads();
    }
}

template <bool NA, int QPITCH, int KPITCH, int V_A, int ASTRIDE>
__device__ __forceinline__ void attn16(rsrc_t R, unsigned q_off, unsigned gqk_off, unsigned k_off, unsigned ssk_off, unsigned vt_off, unsigned y_off, unsigned rpb_off, int qcol0, int kc0, int lane) {
    const int n = lane & 15, kq = lane >> 4;
    const int qcol = qcol0 + n; int cs = qcol - 8; cs = cs < 0 ? 0 : (cs > 48 ? 48 : cs);
    bf16x8 kf[3][8]; f32x4 skv[3][2];
    const unsigned ko = NA ? (unsigned)((n >> 3) * 2048 + kq * 128 + (n & 7) * 16) : (unsigned)(n * KPITCH + 8 * kq) * 2u, so = (unsigned)kq * 16u;
#define ATT_LOADK(a_, b_) do { _Pragma("unroll") for (int t = 0; t < 2; ++t) { \
        _Pragma("unroll") for (int ks = 0; ks < 4; ++ks) kf[b_][t * 4 + ks] = bld<bf16x8>(R, ko, k_off + (NA ? (unsigned)((a_) * 131072 + t * 4096 + ks * 512) : (unsigned)(((a_) * ASTRIDE + 16 * t) * KPITCH + 32 * ks) * 2u)); \
        skv[b_][t] = bld<f32x4>(R, so, ssk_off + (unsigned)((a_) * ASTRIDE + 16 * t) * 4u); } } while (0)
    ATT_LOADK(0, 0); ATT_LOADK(1, 1);
    bf16x8 qf[4];
    { float qv[4][8]; float ss = 0.f; const unsigned qo = (unsigned)(n * QPITCH + 8 * kq) * 2u;
#pragma unroll
      for (int ks = 0; ks < 4; ++ks) { const u32x4 raw = bld<u32x4>(R, qo, q_off + 64 * ks);
#pragma unroll
          for (int j = 0; j < 4; ++j) { const unsigned w = raw[j]; qv[ks][2 * j] = __builtin_bit_cast(float, w << 16); qv[ks][2 * j + 1] = __builtin_bit_cast(float, w & 0xffff0000u); ss += qv[ks][2 * j] * qv[ks][2 * j] + qv[ks][2 * j + 1] * qv[ks][2 * j + 1]; } }
      ss = pg8::sum_fq(ss);
      const float rq = __builtin_amdgcn_rsqf(ss * (1.f / HD) + EPS);
#pragma unroll
      for (int ks = 0; ks < 4; ++ks) { const f32x4 g0 = bld<f32x4>(R, (unsigned)kq * 32u, gqk_off + 128 * ks), g1 = bld<f32x4>(R, (unsigned)kq * 32u, gqk_off + 128 * ks + 16);
          u32x4 w; w.x = pg8::cvt_pk_bf16(qv[ks][0] * rq * g0[0], qv[ks][1] * rq * g0[1]); w.y = pg8::cvt_pk_bf16(qv[ks][2] * rq * g0[2], qv[ks][3] * rq * g0[3]);
          w.z = pg8::cvt_pk_bf16(qv[ks][4] * rq * g1[0], qv[ks][5] * rq * g1[1]); w.w = pg8::cvt_pk_bf16(qv[ks][6] * rq * g1[2], qv[ks][7] * rq * g1[3]);
          qf[ks] = __builtin_bit_cast(bf16x8, w); } }
    f32x4 S[8][2];
#pragma unroll
    for (int a = 0; a < 8; ++a) {
        if (a < 6) ATT_LOADK(a + 2, (a + 2) % 3);
        SCHED_FENCE();
#pragma unroll
        for (int t = 0; t < 2; ++t) {
            f32x4 acc = (f32x4){0.f, 0.f, 0.f, 0.f};
#pragma unroll
            for (int ks = 0; ks < 4; ++ks) acc = MFMA16(kf[a % 3][t * 4 + ks], qf[ks], acc);
#pragma unroll
            for (int j = 0; j < 4; ++j) S[a][t][j] = acc[j] * __builtin_amdgcn_rsqf(skv[a % 3][t][j] * (1.f / HD) + EPS);
        }
    }
#undef ATT_LOADK
    u32x2 vlo[2][8], vhi[2][8];
    const unsigned vo = (unsigned)(n * 8 + kq * 1024);
#define ATT_LOADV(a_, b_) do { _Pragma("unroll") for (int dt = 0; dt < 8; ++dt) { vlo[b_][dt] = bld<u32x2>(R, vo, vt_off + (unsigned)(dt * 128 + (a_) * V_A)); vhi[b_][dt] = bld<u32x2>(R, vo, vt_off + (unsigned)(dt * 128 + (a_) * V_A + 4096)); } } while (0)
    ATT_LOADV(0, 0);
    if (NA) {
        unsigned bo[8]; float bb[8][8];
#pragma unroll
        for (int q = 0; q < 8; ++q) { int ci = kc0 + 16 * (q >> 2) + 4 * kq + (q & 3) - qcol + 15; ci = ci < 0 ? 0 : (ci > 30 ? 30 : ci); bo[q] = (unsigned)ci * 4u; }
#pragma unroll
        for (int a = 0; a < 8; ++a)
#pragma unroll
            for (int q = 0; q < 8; ++q) bb[a][q] = bld<float>(R, bo[q], rpb_off + (unsigned)a * 124u);
        SCHED_FENCE();
#pragma unroll
        for (int a = 0; a < 8; ++a)
#pragma unroll
            for (int q = 0; q < 8; ++q) { const int kcol = kc0 + 16 * (q >> 2) + 4 * kq + (q & 3); const bool valid = (kcol >= cs) && (kcol < cs + 16); S[a][q >> 2][q & 3] = valid ? S[a][q >> 2][q & 3] + bb[a][q] : -1e30f; }
    }
    SCHED_FENCE();
    float mx = -3e38f;
#pragma unroll
    for (int a = 0; a < 8; ++a)
#pragma unroll
        for (int t = 0; t < 2; ++t)
#pragma unroll
            for (int j = 0; j < 4; ++j) mx = fmaxf(mx, S[a][t][j]);
    mx = pg8::max_fq(mx);
    float sum = 0.f;
#pragma unroll
    for (int a = 0; a < 8; ++a) {
#pragma unroll
        for (int t = 0; t < 2; ++t)
#pragma unroll
            for (int j = 0; j < 4; ++j) { const float p = __expf(S[a][t][j] - mx); S[a][t][j] = p; sum += p; }
        SCHED_FENCE();
    }
    sum = pg8::sum_fq(sum);
    f32x4 o[8];
#pragma unroll
    for (int dt = 0; dt < 8; ++dt) o[dt] = (f32x4){0.f, 0.f, 0.f, 0.f};
#pragma unroll
    for (int a = 0; a < 8; ++a) {
        if (a < 7) ATT_LOADV(a + 1, (a + 1) & 1);
        SCHED_FENCE();
        const u32x4 pw = pg8::pack8(S[a][0], S[a][1]); const bf16x8 pf = __builtin_bit_cast(bf16x8, pw);
#pragma unroll
        for (int dt = 0; dt < 8; ++dt) { const u32x4 vw = (u32x4){vlo[a & 1][dt].x, vlo[a & 1][dt].y, vhi[a & 1][dt].x, vhi[a & 1][dt].y}; o[dt] = MFMA16(__builtin_bit_cast(bf16x8, vw), pf, o[dt]); }
        SCHED_FENCE();
    }
#undef ATT_LOADV
    const float inv = __builtin_amdgcn_rcpf(sum); float ss = 0.f;
#pragma unroll
    for (int dt = 0; dt < 8; ++dt) { o[dt] = o[dt] * inv; ss += pg8::sq4(o[dt]); }
    ss = pg8::sum_fq(ss);
    const float rn = __builtin_amdgcn_rsqf(ss * (1.f / HD) + EPS);
    const unsigned yo = (unsigned)(n * DM + 4 * kq) * 2u;
#pragma unroll
    for (int dt = 0; dt < 8; ++dt) { u32x2 w; w.x = pg8::cvt_pk_bf16(o[dt][0] * rn, o[dt][1] * rn); w.y = pg8::cvt_pk_bf16(o[dt][2] * rn, o[dt][3] * rn); bst<u32x2>(R, yo, y_off + 32 * dt, w); }
}

constexpr int MK_ROWB = 272, MV_KGB = 1152, MEM_LDS_V = 256 * MK_ROWB, MEM_LDS_S = MEM_LDS_V + 64 * MV_KGB;
static_assert(MEM_LDS_S + 1024 <= LDS_BYTES - 64, "memory attention LDS map");
__device__ __forceinline__ void mem_attn_block(LAS unsigned char* lds, rsrc_t R, int l, int bx, int G, int tid, int lane, int wave) {
    const int n = lane & 15, kq = lane >> 4;
#pragma unroll 1
    for (int u = bx; u < 256; u += G) {
        const int bh = u >> 4, qr = u & 15, b = bh >> 2, h = bh & 3;
        { const unsigned kvo = (unsigned)((tid >> 4) * 1024 + (tid & 15) * 16), ksb = OFF_KM + (unsigned)(l * 1024 * 512 + b * NMEM * 512 + h * HD) * 2u;
          const unsigned vsb = OFF_VMT + (unsigned)(l * 1048576 + (b * 4 + h) * 65536);
          u32x4 kv[8], vv[8];
#pragma unroll
          for (int i = 0; i < 8; ++i) { kv[i] = bld<u32x4>(R, kvo, ksb + (unsigned)i * 32768u); vv[i] = bld<u32x4>(R, (unsigned)tid * 16u, vsb + (unsigned)i * 8192u); }
          float ssv = 1.f; if (tid < 256) ssv = bld<float>(R, (unsigned)tid * 4u, OFF_SS + (unsigned)(SS_MK + (l * 4 + h) * 1024 + b * NMEM) * 4u);
#pragma unroll
          for (int i = 0; i < 8; ++i) { *(LAS u32x4*)(lds + ((tid >> 4) + 32 * i) * MK_ROWB + (tid & 15) * 16) = kv[i]; *(LAS u32x4*)(lds + MEM_LDS_V + ((tid >> 6) + 8 * i) * MV_KGB + (tid & 63) * 16) = vv[i]; }
          if (tid < 256) *(LAS float*)(lds + MEM_LDS_S + tid * 4) = __builtin_amdgcn_rsqf(ssv * (1.f / HD) + EPS); }
        __syncthreads();
        int kb = n * MK_ROWB + kq * 16; asm volatile("" : "+v"(kb));
        int vb0 = MEM_LDS_V + kq * MV_KGB + n * 8; asm volatile("" : "+v"(vb0));
        int vb1 = MEM_LDS_V + (kq + 32) * MV_KGB + n * 8; asm volatile("" : "+v"(vb1));
        int sb = MEM_LDS_S + kq * 16; asm volatile("" : "+v"(sb));
        const unsigned qo = (unsigned)(n * PROJ_W + 8 * kq) * 2u, yo = (unsigned)(n * DM + 4 * kq) * 2u;
        const int tok0 = b * SEQ + qr * 512 + wave * 64;
        const unsigned gqk_off = OFF_GQK + (unsigned)((l * 2 + 1) * HD) * 4u;
        u32x4 raw[4];
#pragma unroll
        for (int ks = 0; ks < 4; ++ks) raw[ks] = bld<u32x4>(R, qo, OFF_PROJ + (unsigned)(tok0 * PROJ_W + 2560 + h * HD) * 2u + 64 * ks);
#pragma unroll 1
        for (int i = 0; i < 4; ++i) {
            bf16x8 qf[4];
            { float qv[4][8]; float ss = 0.f;
#pragma unroll
              for (int ks = 0; ks < 4; ++ks)
#pragma unroll
                  for (int j = 0; j < 4; ++j) { const unsigned w = raw[ks][j]; qv[ks][2 * j] = __builtin_bit_cast(float, w << 16); qv[ks][2 * j + 1] = __builtin_bit_cast(float, w & 0xffff0000u); ss += qv[ks][2 * j] * qv[ks][2 * j] + qv[ks][2 * j + 1] * qv[ks][2 * j + 1]; }
              ss = pg8::sum_fq(ss);
              const float rq = __builtin_amdgcn_rsqf(ss * (1.f / HD) + EPS);
#pragma unroll
              for (int ks = 0; ks < 4; ++ks) { const f32x4 g0 = bld<f32x4>(R, (unsigned)kq * 32u, gqk_off + 128 * ks), g1 = bld<f32x4>(R, (unsigned)kq * 32u, gqk_off + 128 * ks + 16);
                  u32x4 w; w.x = pg8::cvt_pk_bf16(qv[ks][0] * rq * g0[0], qv[ks][1] * rq * g0[1]); w.y = pg8::cvt_pk_bf16(qv[ks][2] * rq * g0[2], qv[ks][3] * rq * g0[3]);
                  w.z = pg8::cvt_pk_bf16(qv[ks][4] * rq * g1[0], qv[ks][5] * rq * g1[1]); w.w = pg8::cvt_pk_bf16(qv[ks][6] * rq * g1[2], qv[ks][7] * rq * g1[3]);
                  qf[ks] = __builtin_bit_cast(bf16x8, w); } }
            { const int tn = tok0 + 16 * (i < 3 ? i + 1 : i);
#pragma unroll
              for (int ks = 0; ks < 4; ++ks) raw[ks] = bld<u32x4>(R, qo, OFF_PROJ + (unsigned)(tn * PROJ_W + 2560 + h * HD) * 2u + 64 * ks); }
            f32x4 S[8][2];
#pragma unroll
            for (int a = 0; a < 8; ++a) {
#pragma unroll
                for (int t = 0; t < 2; ++t) {
                    f32x4 acc = (f32x4){0.f, 0.f, 0.f, 0.f};
#pragma unroll
                    for (int ks = 0; ks < 4; ++ks) { const bf16x8 kf = *(const LAS bf16x8*)(lds + kb + (32 * a + 16 * t) * MK_ROWB + 64 * ks); acc = MFMA16(kf, qf[ks], acc); }
                    const f32x4 rk = *(const LAS f32x4*)(lds + sb + (32 * a + 16 * t) * 4);
                    S[a][t] = acc * rk;
                }
                SCHED_FENCE();
            }
            float mx = -3e38f;
#pragma unroll
            for (int a = 0; a < 8; ++a)
#pragma unroll
                for (int t = 0; t < 2; ++t)
#pragma unroll
                    for (int j = 0; j < 4; ++j) mx = fmaxf(mx, S[a][t][j]);
            mx = pg8::max_fq(mx);
            float sum = 0.f;
#pragma unroll
            for (int a = 0; a < 8; ++a) {
#pragma unroll
                for (int t = 0; t < 2; ++t)
#pragma unroll
                    for (int j = 0; j < 4; ++j) { const float p = __expf(S[a][t][j] - mx); S[a][t][j] = p; sum += p; }
                SCHED_FENCE();
            }
            sum = pg8::sum_fq(sum);
            f32x4 o[8];
#pragma unroll
            for (int dt = 0; dt < 8; ++dt) o[dt] = (f32x4){0.f, 0.f, 0.f, 0.f};
#pragma unroll
            for (int a = 0; a < 8; ++a) {
                const u32x4 pw = pg8::pack8(S[a][0], S[a][1]); const bf16x8 pf = __builtin_bit_cast(bf16x8, pw);
#pragma unroll
                for (int dt = 0; dt < 8; ++dt) {
                    const int vb = (a < 4) ? vb0 : vb1; const int off = (8 * (a & 3)) * MV_KGB + dt * 128;
                    const u32x2 lo = *(const LAS u32x2*)(lds + vb + off), hi = *(const LAS u32x2*)(lds + vb + off + 4 * MV_KGB);
                    const u32x4 vw = (u32x4){lo.x, lo.y, hi.x, hi.y}; o[dt] = MFMA16(__builtin_bit_cast(bf16x8, vw), pf, o[dt]); }
                SCHED_FENCE();
            }
            const float inv = __builtin_amdgcn_rcpf(sum); float ss = 0.f;
#pragma unroll
            for (int dt = 0; dt < 8; ++dt) { o[dt] = o[dt] * inv; ss += pg8::sq4(o[dt]); }
            ss = pg8::sum_fq(ss);
            const float rn = __builtin_amdgcn_rsqf(ss * (1.f / HD) + EPS);
            const unsigned y_off = OFF_Y + (unsigned)((tok0 + 16 * i) * DM + 1536 + h * HD) * 2u;
#pragma unroll
            for (int dt = 0; dt < 8; ++dt) { u32x2 w; w.x = pg8::cvt_pk_bf16(o[dt][0] * rn, o[dt][1] * rn); w.y = pg8::cvt_pk_bf16(o[dt][2] * rn, o[dt][3] * rn); bst<u32x2>(R, yo, y_off + 32 * dt, w); }
        }
        __syncthreads();
    }
}

constexpr int NA_BUF = 32768, NA_SSK = 2 * NA_BUF, NA_RPB = NA_SSK + 4096, NA_LDS_END = NA_RPB + 8 * 15 * 31 * 4;
static_assert(NA_LDS_END <= LDS_BYTES - 64, "neighbourhood attention LDS map");
__device__ __forceinline__ void na_attn_block(LAS unsigned char* lds, rsrc_t R, int l, int bx, int G, int tid, int lane, int wave) {
    const int n = lane & 15, kq = lane >> 4, qg = wave & 3, hsel = wave >> 2;
    const int kc0 = (qg == 0) ? 0 : (qg == 1 ? 8 : (qg == 2 ? 24 : 32));
    const int qcol = 16 * qg + n; int cs = qcol - 8; cs = cs < 0 ? 0 : (cs > 48 ? 48 : cs);
    for (int i = tid; i < 8 * 15 * 31; i += NWAVES * 64) *(LAS float*)(lds + NA_RPB + i * 4) = bld<float>(R, (unsigned)i * 4u, OFF_RPB + (unsigned)(l * 8 * 15 * 31) * 4u);
    const unsigned co = (unsigned)tid * 16u;
    int kfb = hsel * 16384 + ((kc0 >> 3) + (n >> 3)) * 2048 + kq * 128 + (n & 7) * 16;
    int vfb = hsel * 16384 + ((kc0 >> 2) + kq) * 1024 + n * 8;
    int skb = NA_SSK + (hsel * 64 + kc0 + 4 * kq) * 4;
    asm volatile("" : "+v"(kfb), "+v"(vfb), "+v"(skb));
    const unsigned qo = (unsigned)(n * PROJ_W + 8 * kq) * 2u, yo = (unsigned)(n * DM + 4 * kq) * 2u;
    const unsigned gqk_off = OFF_GQK + (unsigned)((l * 2 + 0) * HD) * 4u;
    f32x4 gq[4][2];
#pragma unroll
    for (int ks = 0; ks < 4; ++ks) { gq[ks][0] = bld<f32x4>(R, (unsigned)kq * 32u, gqk_off + 128 * ks); gq[ks][1] = bld<f32x4>(R, (unsigned)kq * 32u, gqk_off + 128 * ks + 16); }
#pragma unroll 1
    for (int u = bx; u < BATCH * 128 * 4; u += G) {
        const int hp = u & 3, r = (u >> 2) & 127, b = u >> 9, h = 2 * hp + hsel;
        int start = r - 4; start = start < 0 ? 0 : (start > 120 ? 120 : start);
        const unsigned rowb = (unsigned)(((b * 128 + start) * 8 + 2 * hp) * 16384);
        u32x4 st[3][4];
#define NA_ISSUE(seq_, slot_) do { _Pragma("unroll") for (int j = 0; j < 4; ++j) st[slot_][j] = bld<u32x4>(R, co, ((seq_) < 8 ? (unsigned)WS_KB + rowb + (unsigned)((seq_) * 131072) : OFF_VT + rowb + (unsigned)(((seq_) - 8) * 131072)) + (unsigned)j * 8192u); } while (0)
#define NA_WRITE(slot_, buf_) do { _Pragma("unroll") for (int j = 0; j < 4; ++j) *(LAS u32x4*)(lds + (buf_) * NA_BUF + j * 8192 + tid * 16) = st[slot_][j]; } while (0)
        u32x4 qraw[4]; float s0, s1;
        { const unsigned q_off = OFF_PROJ + (unsigned)((b * SEQ + r * 64 + 16 * qg) * PROJ_W + h * HD) * 2u;
#pragma unroll
          for (int ks = 0; ks < 4; ++ks) qraw[ks] = bld<u32x4>(R, qo, q_off + 64 * ks);
          const int hs = wave & 1, a0 = wave >> 1;
          const unsigned sso = OFF_SS + (unsigned)(SS_H + (size_t)(l * 20 + 2 * hp + hs) * NTOK + b * SEQ + (start + a0) * 64) * 4u;
          s0 = bld<float>(R, (unsigned)(lane * 4), sso); s1 = bld<float>(R, (unsigned)(lane * 4), sso + 4u * 64u * 4u); }
        SCHED_FENCE();
        NA_ISSUE(0, 0); NA_ISSUE(1, 1); NA_ISSUE(2, 2);
        SCHED_FENCE();
        *(LAS float*)(lds + NA_SSK + tid * 4) = __builtin_amdgcn_rsqf(s0 * (1.f / HD) + EPS); *(LAS float*)(lds + NA_SSK + (tid + 512) * 4) = __builtin_amdgcn_rsqf(s1 * (1.f / HD) + EPS);
        bf16x8 qf[4];
        { float qv[4][8]; float ss = 0.f;
#pragma unroll
          for (int ks = 0; ks < 4; ++ks)
#pragma unroll
              for (int j = 0; j < 4; ++j) { const unsigned w = qraw[ks][j]; qv[ks][2 * j] = __builtin_bit_cast(float, w << 16); qv[ks][2 * j + 1] = __builtin_bit_cast(float, w & 0xffff0000u); ss += qv[ks][2 * j] * qv[ks][2 * j] + qv[ks][2 * j + 1] * qv[ks][2 * j + 1]; }
          ss = pg8::sum_fq(ss);
          const float rq = __builtin_amdgcn_rsqf(ss * (1.f / HD) + EPS);
#pragma unroll
          for (int ks = 0; ks < 4; ++ks) { const f32x4 g0 = gq[ks][0], g1 = gq[ks][1];
              u32x4 w; w.x = pg8::cvt_pk_bf16(qv[ks][0] * rq * g0[0], qv[ks][1] * rq * g0[1]); w.y = pg8::cvt_pk_bf16(qv[ks][2] * rq * g0[2], qv[ks][3] * rq * g0[3]);
              w.z = pg8::cvt_pk_bf16(qv[ks][4] * rq * g1[0], qv[ks][5] * rq * g1[1]); w.w = pg8::cvt_pk_bf16(qv[ks][6] * rq * g1[2], qv[ks][7] * rq * g1[3]);
              qf[ks] = __builtin_bit_cast(bf16x8, w); } }
        NA_WRITE(0, 0);
        __syncthreads();
        f32x4 S[8][2];
#pragma unroll
        for (int a = 0; a < 8; ++a) {
            NA_ISSUE(a + 3, a % 3);
            SCHED_FENCE();
            const int buf = (a & 1) * NA_BUF;
#pragma unroll
            for (int t = 0; t < 2; ++t) {
                f32x4 acc = (f32x4){0.f, 0.f, 0.f, 0.f};
#pragma unroll
                for (int ks = 0; ks < 4; ++ks) { const bf16x8 kf = *(const LAS bf16x8*)(lds + kfb + buf + t * 4096 + ks * 512); acc = MFMA16(kf, qf[ks], acc); }
                const f32x4 rk = *(const LAS f32x4*)(lds + skb + a * 512 + t * 64);
                S[a][t] = acc * rk;
            }
            SCHED_FENCE();
            NA_WRITE((a + 1) % 3, (a + 1) & 1);
            __syncthreads();
        }
        { const int rowidx0 = start - r + 7;
#pragma unroll
          for (int a = 0; a < 8; ++a)
#pragma unroll
              for (int q = 0; q < 8; ++q) { const int kcol = kc0 + 16 * (q >> 2) + 4 * kq + (q & 3); const bool valid = (kcol >= cs) && (kcol < cs + 16);
                  int ci = kcol - qcol + 15; ci = ci < 0 ? 0 : (ci > 30 ? 30 : ci);
                  const float bias = *(const LAS float*)(lds + NA_RPB + ((h * 15 + rowidx0 + a) * 31 + ci) * 4);
                  S[a][q >> 2][q & 3] = valid ? S[a][q >> 2][q & 3] + bias : -1e30f; } }
        float mx = -3e38f;
#pragma unroll
        for (int a = 0; a < 8; ++a)
#pragma unroll
            for (int t = 0; t < 2; ++t)
#pragma unroll
                for (int j = 0; j < 4; ++j) mx = fmaxf(mx, S[a][t][j]);
        mx = pg8::max_fq(mx);
        float sum = 0.f;
#pragma unroll
        for (int a = 0; a < 8; ++a) {
#pragma unroll
            for (int t = 0; t < 2; ++t)
#pragma unroll
                for (int j = 0; j < 4; ++j) { const float p = __expf(S[a][t][j] - mx); S[a][t][j] = p; sum += p; }
            SCHED_FENCE();
        }
        sum = pg8::sum_fq(sum);
        f32x4 o[8];
#pragma unroll
        for (int dt = 0; dt < 8; ++dt) o[dt] = (f32x4){0.f, 0.f, 0.f, 0.f};
#pragma unroll
        for (int a = 0; a < 8; ++a) {
            if (a + 3 < 8) NA_ISSUE(8 + a + 3, (8 + a) % 3);
            SCHED_FENCE();
            const int buf = (a & 1) * NA_BUF;
            const u32x4 pw = pg8::pack8(S[a][0], S[a][1]); const bf16x8 pf = __builtin_bit_cast(bf16x8, pw);
#pragma unroll
            for (int dt = 0; dt < 8; ++dt) { const u32x2 lo = *(const LAS u32x2*)(lds + vfb + buf + dt * 128), hi = *(const LAS u32x2*)(lds + vfb + buf + dt * 128 + 4096);
                const u32x4 vw = (u32x4){lo.x, lo.y, hi.x, hi.y}; o[dt] = MFMA16(__builtin_bit_cast(bf16x8, vw), pf, o[dt]); }
            SCHED_FENCE();
            if (a < 7) NA_WRITE((8 + a + 1) % 3, (a + 1) & 1);
            __syncthreads();
        }
#undef NA_ISSUE
#undef NA_WRITE
        const float inv = __builtin_amdgcn_rcpf(sum); float ss = 0.f;
#pragma unroll
        for (int dt = 0; dt < 8; ++dt) { o[dt] = o[dt] * inv; ss += pg8::sq4(o[dt]); }
        ss = pg8::sum_fq(ss);
        const float rn = __builtin_amdgcn_rsqf(ss * (1.f / HD) + EPS);
        const unsigned y_off = OFF_Y + (unsigned)((b * SEQ + r * 64 + 16 * qg) * DM + h * HD) * 2u;
#pragma unroll
        for (int dt = 0; dt < 8; ++dt) { u32x2 w; w.x = pg8::cvt_pk_bf16(o[dt][0] * rn, o[dt][1] * rn); w.y = pg8::cvt_pk_bf16(o[dt][2] * rn, o[dt][3] * rn); bst<u32x2>(R, yo, y_off + 32 * dt, w); }
    }
}

#define RLX_AGENT __ATOMIC_RELAXED, __HIP_MEMORY_SCOPE_AGENT
#define XB_TMO      128
#define XB_XCNT(j)  (256  + 64 * (j))
#define XB_XSUB(j)  (1280 + 64 * (j))
#define XB_XGEN(j)  (2304 + 64 * (j))
#define XB_TOP      3328
#define XB_TOPGEN   3392
#define XCD_BAR_WORDS 3456
#define XB_SPIN_CAP (1u << 18)

__device__ __forceinline__ unsigned xb_ld(unsigned* p)              { return __hip_atomic_load(p, __ATOMIC_RELAXED, __HIP_MEMORY_SCOPE_AGENT); }
__device__ __forceinline__ unsigned xb_add(unsigned* p, unsigned v) { return __hip_atomic_fetch_add(p, v, __ATOMIC_RELAXED, __HIP_MEMORY_SCOPE_AGENT); }
__device__ __forceinline__ unsigned xb_xcc_id() { return (unsigned)__builtin_amdgcn_s_getreg((3 << 11) | 20) & 0xFu; }
#define XB_SPIN(cond, bar) do { unsigned _sp = 0; while (cond) { __builtin_amdgcn_s_sleep(1); \
    if ((++_sp & 255u) == 0u) { if (xb_ld(&(bar)[XB_TMO])) break; if (_sp > XB_SPIN_CAP) { atomicAdd(&(bar)[XB_TMO], 1u); break; } } } } while (0)

struct XcdBarrier {
    unsigned* bar; unsigned x;
    volatile LAS unsigned* st;
};

__device__ __forceinline__ XcdBarrier xcd_barrier_post(unsigned* bar, volatile LAS unsigned* st) {
    XcdBarrier b; b.bar = bar; b.x = xb_xcc_id(); b.st = st;
    if (threadIdx.x == 0) (void)xb_add(&bar[XB_XCNT(b.x)], 1u);
    return b;
}
__device__ __forceinline__ void xcd_barrier_complete(unsigned* bar, unsigned x, unsigned& nloc, unsigned& nx) {
    const unsigned G = gridDim.x * gridDim.y * gridDim.z;
    unsigned sum, cnt, mine, sp = 0u;
    for (;;) {
        sum = 0u; cnt = 0u; mine = 0u;
#pragma unroll
        for (unsigned j = 0; j < 16; ++j) { const unsigned c = xb_ld(&bar[XB_XCNT(j)]); sum += c; cnt += (c > 0u) ? 1u : 0u; mine = (j == x) ? c : mine; }
        if (sum == G) break;
        __builtin_amdgcn_s_sleep(1);
        if ((++sp & 255u) == 0u) { if (xb_ld(&bar[XB_TMO])) break; if (sp > XB_SPIN_CAP) { atomicAdd(&bar[XB_TMO], 1u); break; } }
    }
    nloc = mine > 0u ? mine : 1u; nx = cnt > 0u ? cnt : 1u;
}

__device__ __forceinline__ void xcd_barrier(const XcdBarrier& b) {
    asm volatile("s_waitcnt vmcnt(0)" ::: "memory");
    __syncthreads();
    if (threadIdx.x == 0) {
        unsigned* bar = b.bar;
        __builtin_amdgcn_s_waitcnt(0);
        unsigned nloc = b.st[0], nx = b.st[1];
        if (nloc == 0u) { xcd_barrier_complete(bar, b.x, nloc, nx); b.st[0] = nloc; b.st[1] = nx; }
        const unsigned old = xb_add(&bar[XB_XSUB(b.x)], 1u);
        const unsigned gen = old / nloc;
        if (old + 1u == (gen + 1u) * nloc) {
            __builtin_amdgcn_fence(__ATOMIC_RELEASE, "agent");
            asm volatile("s_waitcnt vmcnt(0)" ::: "memory");
            const unsigned og = xb_add(&bar[XB_TOP], 1u);
            const unsigned tg = og / nx;
            if (og + 1u == (tg + 1u) * nx) xb_add(&bar[XB_TOPGEN], 1u);
            else XB_SPIN(xb_ld(&bar[XB_TOPGEN]) == tg, bar);
            __builtin_amdgcn_fence(__ATOMIC_ACQUIRE, "agent");
            xb_add(&bar[XB_XGEN(b.x)], 1u);
            asm volatile("s_waitcnt vmcnt(0)" ::: "memory");
        } else {
            XB_SPIN(xb_ld(&bar[XB_XGEN(b.x)]) == gen, bar);
            __builtin_amdgcn_fence(__ATOMIC_ACQUIRE, "agent");
            asm volatile("s_waitcnt vmcnt(0)" ::: "memory");
        }
    }
    __syncthreads();
}

__global__ void __launch_bounds__(NWAVES * 64, 2) mega_fwd(Args args) {
    extern __shared__ __attribute__((aligned(16))) unsigned char lds_raw[];
    LAS unsigned char* lds = (LAS unsigned char*)lds_raw;

    const int wave = __builtin_amdgcn_readfirstlane((int)threadIdx.x >> 6);
    if (threadIdx.x < 16) ((LAS unsigned*)(lds + LDS_BYTES - 64))[threadIdx.x] = 0u;
    __syncthreads();
    const XcdBarrier xbar = xcd_barrier_post((unsigned*)args.ws, (volatile LAS unsigned*)(lds + LDS_BYTES - 64));
    for (int ph = args.ph_lo; ph < args.ph_hi; ++ph) {
        unsigned char* ws = args.ws; asm volatile("" : "+s"(ws));
#define FRESH_TID(name) int name; asm volatile("v_mbcnt_lo_u32_b32 %0, -1, 0\n\tv_mbcnt_hi_u32_b32 %0, -1, %0" : "=v"(name)); name += wave * 64
        const int G = gridDim.x, bx = blockIdx.x, vcu = (G % 8 == 0) ? (bx % 8) * (G / 8) + bx / 8 : bx;
        const int gw = vcu * NWAVES + wave, NGW = G * NWAVES;
        float* ss = (float*)(ws + WS_SS);
        bf16_t* xb = (bf16_t*)(ws + WS_XB); bf16_t* proj = (bf16_t*)(ws + WS_PROJ); bf16_t* VT = (bf16_t*)(ws + WS_VT); bf16_t* yb = (bf16_t*)(ws + WS_Y);
        bf16_t* A2r = (bf16_t*)(ws + WS_A2); bf16_t* A2i = A2r + (size_t)16 * 64 * 128 * 128; bf16_t* hid = (bf16_t*)(ws + WS_H);
        bf16_t* memb = (bf16_t*)(ws + WS_MEMB); bf16_t* Km = (bf16_t*)(ws + WS_KM); bf16_t* VmT = (bf16_t*)(ws + WS_VMT);
        const bf16_t* T64 = (const bf16_t*)(ws + WS_TAB + TAB_T64); const bf16_t* T128 = (const bf16_t*)(ws + WS_TAB + TAB_T128); const bf16_t* MT = (const bf16_t*)(ws + WS_TAB + TAB_MT); const float* GQK = (const float*)(ws + WS_TAB + TAB_GQK);
        if (ph < NPRO) { FRESH_TID(tid); prologue(args, ws, lds, tid, tid & 63, wave, vcu, G); }
        else {
            const int l = (ph - NPRO) / LSEQ_N, k = (int)((LSEQ >> (4 * ((ph - NPRO) % LSEQ_N))) & 15ull);
            float* ssx_in1 = ss + SS_X + (size_t)(2 * l) * NTOK;
            float* ssx_mid = ss + SS_X + (size_t)(2 * l + 1) * NTOK;
            float* ssx_out = ss + SS_X + (size_t)(2 * l + 2) * NTOK;
            float* sshl = ss + SS_H + (size_t)l * 20 * NTOK;
            if (k == 0) {
                const int n1 = (l == 0) ? 3 : 1;
#pragma unroll 1
                for (int gi = 0; gi < n1; ++gi) {
                    pg8::Gemm g; pg8::EpiProj E; pg8::StaticOrder S;
                    if (gi == 0) { g = pg8::Gemm{xb, (const bf16_t*)(ws + WS_WIN) + (size_t)l * DIN * DM, NTOK, PROJ_W, DM};
                        E = pg8::EpiProj{proj, PROJ_W, ssx_in1, 1.f / DM, sshl, NTOK, 4, 8, (bf16_t*)(ws + WS_KB), 4, 8}; S.init(NTOK, PROJ_W, G, bx); }
                    else { const int lm = gi - 1;
                        g = pg8::Gemm{memb, (const bf16_t*)(ws + WS_WMKV) + (size_t)lm * 1024 * DM, BATCH * NMEM, 512, DM};
                        E = pg8::EpiProj{Km + (size_t)lm * 1024 * 512, 512, nullptr, 0.f, ss + SS_MK + (size_t)lm * 4 * 1024 - (size_t)0, 1024, 0, 2, nullptr, 1000, 1000}; S.init(BATCH * NMEM, 512, G, (bx + G - 8 * lm) % G); }
                    pg8::gemm_phase<pg8::EpiProj, pg8::StaticOrder, PG8_ALIGN, PG8_SP2>(lds, g, S, E, wave);
                }
#pragma unroll 1
                for (int gi = 0; gi < n1; ++gi) {
                    pg8::Gemm g; pg8::EpiColScale E; pg8::StaticOrder S;
                    if (gi == 0) { g = pg8::Gemm{(const bf16_t*)(ws + WS_WIN) + (size_t)l * DIN * DM + (size_t)3072 * DM, xb, 1024, NTOK, DM};
                        E = pg8::EpiColScale{VT, 6, 8, ssx_in1, 1.f / DM}; S.init(1024, NTOK, G, bx); }
                    else { const int lm = gi - 1;
                        g = pg8::Gemm{(const bf16_t*)(ws + WS_WMKV) + (size_t)lm * 1024 * DM + (size_t)512 * DM, memb, 512, BATCH * NMEM, DM};
                        E = pg8::EpiColScale{VmT + (size_t)lm * 512 * 1024, 8, 4, nullptr, 0.f}; S.init(512, BATCH * NMEM, G, (bx + G - 16 - 8 * lm) % G); }
                    pg8::gemm_phase<pg8::EpiColScale, pg8::StaticOrder, PG8_ALIGN, PG8_SP2>(lds, g, S, E, wave);
                }
            } else if (k == 1) {
                FRESH_TID(tid); const int lane = tid & 63;
                const rsrc_t R = make_rsrc(ws);
                for (int it = gw; it < 16 * 128; it += NGW) fourier_stage_a(R, it, lane);
                mem_attn_block(lds, R, l, bx, G, tid, lane, wave);
            } else if (k == 2) {
                FRESH_TID(tid); const int lane = tid & 63;
                const rsrc_t R = make_rsrc(ws);
                fourier_stage_c_block(lds, R, l, bx, G, tid, lane, wave);
                na_attn_block(lds, R, l, bx, G, tid, lane, wave);
            } else if (k == 3 || k == 5) {
                pg8::Gemm g; pg8::EpiResid E; pg8::StaticOrder S; S.init(NTOK, DM, G, bx);
                if (k == 3) { g = pg8::Gemm{yb, (const bf16_t*)(ws + WS_WOUT) + (size_t)l * DM * DM, NTOK, DM, DM};
                    E = pg8::EpiResid{xb, nullptr, ssx_mid, DM}; }
                else { g = pg8::Gemm{hid, (const bf16_t*)(ws + WS_WDN) + (size_t)l * DM * DFF, NTOK, DM, DFF};
                    E = pg8::EpiResid{xb, (l == 1) ? args.out : nullptr, ssx_out, DM}; }
                pg8::gemm_phase<pg8::EpiResid, pg8::StaticOrder, PG8_ALIGN, PG8_SP2>(lds, g, S, E, wave);
            } else {
                pg8::Gemm g{xb, (const bf16_t*)(ws + WS_WGU) + (size_t)l * 2 * DFF * DM, NTOK, 2 * DFF, DM}; pg8::StaticOrder S; S.init(NTOK, 2 * DFF, G, bx);
                pg8::EpiSwiGLU E{hid, DFF, ssx_mid, 1.f / DM};
                pg8::gemm_phase<pg8::EpiSwiGLU, pg8::StaticOrder, PG8_ALIGN, PG8_SP2>(lds, g, S, E, wave);
            }
        }
        if (ph + 1 < args.ph_hi) { if (args.ph_lo < 0) cg::this_grid().sync(); else xcd_barrier(xbar); }
    }
}

extern "C" void kernel_launch(void* const* d_in, const int* in_sizes, int n_in, void* d_out, int out_size, void* d_ws, size_t ws_size, hipStream_t stream) {
    static int grid = 0;
    if (grid == 0) {
        if (n_in != 18 || out_size != NTOK * DM || ws_size < WS_END) { fprintf(stderr, "kernel_launch: unexpected shapes (n_in %d, out %d, ws %zu); nothing launched\n", n_in, out_size, ws_size); grid = -1; return; }
        int dev = 0, cus = 0, per_cu = 0;
        (void)hipGetDevice(&dev); (void)hipDeviceGetAttribute(&cus, hipDeviceAttributeMultiprocessorCount, dev);
        if (hipFuncSetAttribute((const void*)mega_fwd, hipFuncAttributeMaxDynamicSharedMemorySize, LDS_BYTES) != hipSuccess) { fprintf(stderr, "kernel_launch: hipFuncSetAttribute failed\n"); grid = -1; return; }
        if (hipOccupancyMaxActiveBlocksPerMultiprocessor(&per_cu, (const void*)mega_fwd, NWAVES * 64, LDS_BYTES) != hipSuccess || per_cu < 1) { fprintf(stderr, "kernel_launch: occupancy query gave %d\n", per_cu); per_cu = 1; }
        (void)hipGetLastError();
        if (cus <= 0) cus = 256;
        grid = cus;
    }
    if (grid < 0) return;
    if (hipMemsetAsync(d_ws, 0, 16384, stream) != hipSuccess) { fprintf(stderr, "kernel_launch: memset of the barrier words failed\n"); return; }
    Args a{};
    for (int i = 0; i < 18; ++i) a.in[i] = (const float*)d_in[i];
    a.out = (float*)d_out; a.ws = (unsigned char*)d_ws;
#if MK_LAUNCHES == 1
    a.ph_lo = 0; a.ph_hi = NPH;
    void* kargs[] = {&a};
    const hipError_t e = hipLaunchCooperativeKernel((const void*)mega_fwd, dim3(grid), dim3(NWAVES * 64), kargs, LDS_BYTES, stream);
    if (e != hipSuccess) fprintf(stderr, "kernel_launch: cooperative launch failed: %s (grid %d)\n", hipGetErrorString(e), grid);
#else
    for (int ph = 0; ph < NPH; ++ph) { a.ph_lo = ph; a.ph_hi = ph + 1; hipLaunchKernelGGL(mega_fwd, dim3(grid), dim3(NWAVES * 64), LDS_BYTES, stream, a); }
#endif
}
```
